# Optimizing an MI355X kernel written in HIP

```python
import jax, jax.numpy as jnp
from jax import lax
import numpy as np

D_MODEL = 1024
BATCH = 32
SEQ = 2048
DEPTH = 4

CHUNK = 64
N_A_LAYERS = DEPTH // 2
N_B_LAYERS = DEPTH - N_A_LAYERS
A_HEADS = 8
A_DQK = D_MODEL // 16
A_DV = D_MODEL // 8
A_QK = A_HEADS * A_DQK
A_V = A_HEADS * A_DV
A_IN = 2 * A_QK + 2 * A_V + 2 * A_HEADS
B_HEADS = 16
B_DH = D_MODEL // B_HEADS
B_DIM = B_HEADS * B_DH
LEFT_CHUNKS = 8
BAND = (LEFT_CHUNKS + 1) * CHUNK
MAX_REL = 256
N_REL = 2 * MAX_REL + 1
D_FF = -(-8 * D_MODEL // (3 * 256)) * 256
EPS = 1e-6
NEG_INIT = -1e30

kernel_name = "yoco_mlstm_chunked_relpos_attn_trunk"


def rmsnorm(x, g):
    x32 = x.astype(jnp.float32)
    y = x32 * lax.rsqrt(jnp.mean(x32 * x32, axis=-1, keepdims=True) + EPS) * g.astype(jnp.float32)
    return y.astype(x.dtype)


def swiglu(h, w_gate, w_up, w_down):
    return (jax.nn.silu(h @ w_gate) * (h @ w_up)) @ w_down


def mlstm_mixer(h, w_in, b_gate, g_head, w_out):
    B, S, _ = h.shape
    nc = S // CHUNK
    proj = h @ w_in
    q = proj[..., :A_QK].astype(jnp.float32).reshape(B, S, A_HEADS, A_DQK)
    k = proj[..., A_QK:2 * A_QK].astype(jnp.float32).reshape(B, S, A_HEADS, A_DQK) * (A_DQK ** -0.5)
    v = proj[..., 2 * A_QK:2 * A_QK + A_V].astype(jnp.float32).reshape(B, S, A_HEADS, A_DV)
    o_pre = proj[..., 2 * A_QK + A_V:2 * A_QK + 2 * A_V]
    gates = proj[..., 2 * A_QK + 2 * A_V:].astype(jnp.float32) + b_gate.astype(jnp.float32)
    i_log = gates[..., :A_HEADS]
    f_log = jax.nn.log_sigmoid(gates[..., A_HEADS:])

    def to_chunks(t):
        return t.reshape(B, nc, CHUNK, A_HEADS, -1).transpose(1, 0, 3, 2, 4)

    def gate_chunks(t):
        return t.reshape(B, nc, CHUNK, A_HEADS).transpose(1, 0, 3, 2)

    tri = jnp.tril(jnp.ones((CHUNK, CHUNK), dtype=bool))

    def step(carry, xs):
        C, n, m = carry
        qc, kc, vc, ic, fc = xs
        b = jnp.cumsum(fc, axis=-1)
        logD = b[..., :, None] - b[..., None, :] + ic[..., None, :]
        logD = jnp.where(tri, logD, -jnp.inf)
        inter = b + m[..., None]
        m_j = jnp.maximum(inter, jnp.max(logD, axis=-1))
        D = jnp.exp(logD - m_j[..., None])
        w_inter = jnp.exp(inter - m_j)
        s = jnp.einsum('bhld,bhsd->bhls', qc, kc) * D
        num = jnp.einsum('bhls,bhsv->bhlv', s, vc) + w_inter[..., None] * jnp.einsum('bhvd,bhld->bhlv', C, qc)
        den = jnp.sum(s, axis=-1) + w_inter * jnp.einsum('bhd,bhld->bhl', n, qc)
        h_out = num / jnp.maximum(jnp.abs(den), jnp.exp(-m_j))[..., None]
        bL = b[..., -1]
        a = bL[..., None] - b + ic
        m_new = jnp.maximum(bL + m, jnp.max(a, axis=-1))
        wa = jnp.exp(a - m_new[..., None])
        decay = jnp.exp(bL + m - m_new)
        C_new = decay[..., None, None] * C + jnp.einsum('bhs,bhsv,bhsd->bhvd', wa, vc, kc)
        n_new = decay[..., None] * n + jnp.einsum('bhs,bhsd->bhd', wa, kc)
        return (C_new, n_new, m_new), h_out

    init = (jnp.zeros((B, A_HEADS, A_DV, A_DQK), jnp.float32),
            jnp.zeros((B, A_HEADS, A_DQK), jnp.float32),
            jnp.full((B, A_HEADS), NEG_INIT, jnp.float32))
    _, hs = lax.scan(step, init, (to_chunks(q), to_chunks(k), to_chunks(v),
                                  gate_chunks(i_log), gate_chunks(f_log)))
    hs = hs.transpose(1, 0, 3, 2, 4).reshape(B, S, A_HEADS, A_DV)
    hs = hs * lax.rsqrt(jnp.mean(hs * hs, axis=-1, keepdims=True) + EPS)
    hs = hs.reshape(B, S, A_V) * g_head.astype(jnp.float32)
    hs = jax.nn.sigmoid(o_pre.astype(jnp.float32)) * hs
    return hs.astype(h.dtype) @ w_out


def chunked_relpos_attention(h, w_q, rel_table, w_o, k_sh, v_sh):
    B, S, _ = h.shape
    nc = S // CHUNK
    q = (h @ w_q).reshape(B, S, B_HEADS, B_DH) * (B_DH ** -0.5)
    q_chunks = q.reshape(B, nc, CHUNK, B_HEADS, B_DH).transpose(1, 0, 2, 3, 4)
    pad = ((0, 0), (LEFT_CHUNKS * CHUNK, 0), (0, 0), (0, 0))
    k_pad = jnp.pad(k_sh, pad)
    v_pad = jnp.pad(v_sh, pad)
    qi = jnp.arange(CHUNK)[:, None]
    kj = jnp.arange(BAND)[None, :]
    dist = LEFT_CHUNKS * CHUNK + qi - kj
    rel_idx = jnp.clip(dist, -MAX_REL, MAX_REL) + MAX_REL
    bias = rel_table.astype(jnp.float32)[:, rel_idx]

    def one_chunk(args):
        c, qc = args
        start = c * CHUNK
        kb = lax.dynamic_slice_in_dim(k_pad, start, BAND, axis=1)
        vb = lax.dynamic_slice_in_dim(v_pad, start, BAND, axis=1)
        s = jnp.einsum('bqhd,bkhd->bhqk', qc, kb).astype(jnp.float32) + bias
        valid = (start - LEFT_CHUNKS * CHUNK + jnp.arange(BAND)) >= 0
        s = jnp.where(valid, s, -jnp.inf)
        p = jax.nn.softmax(s, axis=-1)
        return jnp.einsum('bhqk,bkhd->bqhd', p.astype(vb.dtype), vb)

    out = lax.map(one_chunk, (jnp.arange(nc), q_chunks))
    out = out.transpose(1, 0, 2, 3, 4).reshape(B, S, B_DIM)
    return out @ w_o


def setup_inputs(seed: int = 0) -> dict:
    key = jax.random.key(seed)
    ks = jax.random.split(key, 20)
    nrm = jax.random.normal
    f32 = jnp.float32
    x = nrm(ks[0], (BATCH, SEQ, D_MODEL), f32)
    a_w_in = nrm(ks[1], (N_A_LAYERS, D_MODEL, A_IN), f32) * D_MODEL ** -0.5
    a_b_gate = jnp.concatenate([0.1 * nrm(ks[2], (N_A_LAYERS, A_HEADS), f32),
                                3.0 + 0.5 * nrm(ks[3], (N_A_LAYERS, A_HEADS), f32)], axis=-1)
    a_g_head = 1.0 + 0.05 * nrm(ks[4], (N_A_LAYERS, A_V), f32)
    a_w_out = nrm(ks[5], (N_A_LAYERS, A_V, D_MODEL), f32) * A_V ** -0.5
    b_w_q = nrm(ks[6], (N_B_LAYERS, D_MODEL, B_DIM), f32) * D_MODEL ** -0.5
    b_rel_bias = 0.1 * nrm(ks[7], (N_B_LAYERS, B_HEADS, N_REL), f32)
    b_w_o = nrm(ks[8], (N_B_LAYERS, B_DIM, D_MODEL), f32) * B_DIM ** -0.5
    kv_norm_g = 1.0 + 0.05 * nrm(ks[9], (D_MODEL,), f32)
    w_kv = nrm(ks[10], (D_MODEL, 2 * B_DIM), f32) * D_MODEL ** -0.5
    norm_mix_g = 1.0 + 0.05 * nrm(ks[11], (DEPTH, D_MODEL), f32)
    norm_ffn_g = 1.0 + 0.05 * nrm(ks[12], (DEPTH, D_MODEL), f32)
    ffn_w_gate = nrm(ks[13], (DEPTH, D_MODEL, D_FF), f32) * D_MODEL ** -0.5
    ffn_w_up = nrm(ks[14], (DEPTH, D_MODEL, D_FF), f32) * D_MODEL ** -0.5
    ffn_w_down = nrm(ks[15], (DEPTH, D_FF, D_MODEL), f32) * D_FF ** -0.5
    final_norm_g = 1.0 + 0.05 * nrm(ks[16], (D_MODEL,), f32)
    return {"x": x, "a_w_in": a_w_in, "a_b_gate": a_b_gate, "a_g_head": a_g_head,
            "a_w_out": a_w_out, "b_w_q": b_w_q, "b_rel_bias": b_rel_bias, "b_w_o": b_w_o,
            "kv_norm_g": kv_norm_g, "w_kv": w_kv, "norm_mix_g": norm_mix_g,
            "norm_ffn_g": norm_ffn_g, "ffn_w_gate": ffn_w_gate, "ffn_w_up": ffn_w_up,
            "ffn_w_down": ffn_w_down, "final_norm_g": final_norm_g}


def reference(x, a_w_in, a_b_gate, a_g_head, a_w_out, b_w_q, b_rel_bias, b_w_o,
              kv_norm_g, w_kv, norm_mix_g, norm_ffn_g, ffn_w_gate, ffn_w_up,
              ffn_w_down, final_norm_g):
    B, S, _ = x.shape
    h = x
    k_sh = None
    v_sh = None
    for l in range(DEPTH):
        if l == N_A_LAYERS:
            kv = rmsnorm(h, kv_norm_g) @ w_kv
            k_sh = kv[..., :B_DIM].reshape(B, S, B_HEADS, B_DH)
            v_sh = kv[..., B_DIM:].reshape(B, S, B_HEADS, B_DH)
        hn = rmsnorm(h, norm_mix_g[l])
        if l < N_A_LAYERS:
            h = h + mlstm_mixer(hn, a_w_in[l], a_b_gate[l], a_g_head[l], a_w_out[l])
        else:
            j = l - N_A_LAYERS
            h = h + chunked_relpos_attention(hn, b_w_q[j], b_rel_bias[j], b_w_o[j], k_sh, v_sh)
        h = h + swiglu(rmsnorm(h, norm_ffn_g[l]), ffn_w_gate[l], ffn_w_up[l], ffn_w_down[l])
    return rmsnorm(h, final_norm_g)
```

```cpp
#include <hip/hip_runtime.h>
#include <cstdio>
#include <cstdint>

#ifndef MK_N_LAUNCHES
#define MK_N_LAUNCHES 1
#endif

#define GAS __attribute__((address_space(1)))
#define LAS __attribute__((address_space(3)))
typedef unsigned short bf16;
typedef short bf16x8 __attribute__((ext_vector_type(8)));
typedef float f32x2 __attribute__((ext_vector_type(2)));
typedef float f32x4 __attribute__((ext_vector_type(4)));
typedef float f32x16 __attribute__((ext_vector_type(16)));
typedef unsigned u32x2 __attribute__((ext_vector_type(2)));
typedef unsigned u32x4 __attribute__((ext_vector_type(4)));
typedef __bf16 bf16x2_t __attribute__((ext_vector_type(2)));

constexpr int M = 65536, D = 1024, SEQ = 2048, NBATCH = 32, CH = 64, NCH = 32;
constexpr int AH = 8, DQK = 64, DV = 128, AIN = 3088;
constexpr int BH = 16, DHD = 64, FF = 2816, NREL = 513;
constexpr float EPS = 1e-6f;
constexpr float LOG2E = 1.4426950408889634f;
typedef unsigned long long u64;
constexpr float SSQ_FIX = 1048576.0f;
__device__ __forceinline__ float rstd_of(u64 q) { return __builtin_amdgcn_rsqf((float)q * (1.0f / (1048576.0f * 1024.0f)) + 1e-6f); }

__device__ __forceinline__ unsigned pk_bf16(float lo, float hi) { f32x2 v = {lo, hi}; bf16x2_t b = __builtin_convertvector(v, bf16x2_t); return __builtin_bit_cast(unsigned, b); }
__device__ __forceinline__ float bf_lo(unsigned u) { return __uint_as_float(u << 16); }
__device__ __forceinline__ float bf_hi(unsigned u) { return __uint_as_float(u & 0xffff0000u); }
__device__ __forceinline__ float fast_exp2(float x) { return __builtin_amdgcn_exp2f(x); }
__device__ __forceinline__ float fast_exp(float x) { return __builtin_amdgcn_exp2f(x * LOG2E); }
__device__ __forceinline__ float fast_rcp(float x) { return __builtin_amdgcn_rcpf(x); }

namespace pg8 {
#define PG8_LAS __attribute__((address_space(3)))
typedef unsigned short bf16_t;
constexpr int BM = 256, BK = 64, HALF = 128, HTB = HALF * BK * 2, STAGE_BYTES = 8 * HTB, NXCD = 8, WGM = 8;
constexpr int EPI_T_OFF = STAGE_BYTES + 6144, EPI_T_WAVE = 16 * 144;
constexpr int SIDE_OFF = STAGE_BYTES + 1024, SIDE_BYTES = 2048;

__host__ __device__ __forceinline__ int lds_byte(int r, int c) { const int st = (r >> 4) * 2 + (c >> 5), rr = r & 15, cc = c & 31, ob = rr * 64 + cc * 2; return st * 1024 + (ob ^ (((ob >> 9) & 1) << 5)); }
__host__ __device__ __forceinline__ void stage_rc(int b, int& R, int& C) { const int st = b / 1024, sb = b % 1024, swz = sb ^ (((sb >> 9) & 1) << 5); R = (st >> 1) * 16 + swz / 64; C = (st & 1) * 32 + (swz % 64) / 2; }
__host__ __device__ __forceinline__ int perm32(int rho) { const int n = rho >> 4, i = rho & 15; return 8 * (i >> 2) + 4 * n + (i & 3); }
__host__ __device__ __forceinline__ int perm32k(int rho) { const int n = rho >> 4, i = rho & 15, fq = i >> 2, e = i & 3; return 16 * (fq >> 1) + 4 * (fq & 1) + 8 * n + e; }

struct Unit { int pm, pn; };
struct Gemm { const bf16_t* A; const bf16_t* Bt; int M, N, K; };

struct StaticOrder {
    int nM, nN, nwg, G, c;
    __host__ __device__ void init(int M_, int N_, int G_, int c_) { nM = M_ / BM; nN = N_ / BM; nwg = nM * nN; G = G_; c = c_; }
    __host__ __device__ bool next(int i, Unit& u) const {
        const long L = (long)i * G + c; if (L >= nwg) return false;
        int wgid = (int)L; { const int q = nwg / NXCD, r = nwg % NXCD, xcd = wgid % NXCD, off = wgid / NXCD; wgid = (xcd < r ? xcd * (q + 1) : r * (q + 1) + (xcd - r) * q) + off; }
        const int nig = WGM * nN, gid = wgid / nig, fm = gid * WGM, gsz = (nM - fm) < WGM ? (nM - fm) : WGM;
        u.pm = fm + ((wgid % nig) % gsz); u.pn = (wgid % nig) / gsz; return true;
    }
    __device__ __forceinline__ void a_ready(const Unit&) const {}
    __device__ __forceinline__ void done(const Unit&) const {}
};

template <bool KPERM> struct EpiBf16T {
    static constexpr bool PERM = true, AFTER_DRAIN = false, WIDE = true;
    static __host__ __device__ __forceinline__ int permf(int rho) { return KPERM ? perm32k(rho) : perm32(rho); }
    bf16_t* O; int ldc; int split_cols; bf16_t* O2; const u64* ssq;
    __device__ __forceinline__ void prestage(PG8_LAS unsigned char* lds, const Unit& u, int par, int wid, int lane) const {
        if (wid < 2) { const int t0 = (KPERM ? u.pn : u.pm) * BM + 128 * wid;
            __builtin_amdgcn_global_load_lds((const unsigned*)(ssq + t0 + 2 * lane), (PG8_LAS unsigned*)(lds + SIDE_OFF + par * SIDE_BYTES + wid * 1024), 16, 0, 0); }
    }
    __device__ __forceinline__ void operator()(const f32x4 (&acc)[2][2][4][2], const Unit& u, int wr, int wc, int fr, int fq, const PG8_LAS unsigned char* side, PG8_LAS unsigned char* tl, int lane) const {
        int colt = u.pn * BM; bf16_t* base = O;
        if (split_cols && colt >= split_cols) { base = O2; colt -= split_cols; }
        const PG8_LAS u64* sq = (const PG8_LAS u64*)side;
        float rs[2][4]; f32x4 cs[2][2];
        if constexpr (!KPERM) {
#pragma unroll
            for (int ai = 0; ai < 2; ++ai)
#pragma unroll
                for (int m = 0; m < 4; ++m) rs[ai][m] = rstd_of(sq[wr * 64 + fr + ai * HALF + m * 16]);
        } else {
            const int tok0 = wc * 64 + 16 * (fq >> 1) + 4 * (fq & 1);
#pragma unroll
            for (int bj = 0; bj < 2; ++bj)
#pragma unroll
                for (int n = 0; n < 2; ++n) {
#pragma unroll
                    for (int e = 0; e < 4; ++e) cs[bj][n][e] = rstd_of(sq[tok0 + bj * 32 + 8 * n + e]); }
        }
        PG8_LAS unsigned char* wp = tl + fr * 144 + fq * 16;
        const PG8_LAS unsigned char* rp = tl + (lane >> 3) * 144 + (lane & 7) * 16;
        bf16_t* gp = base + (size_t)(u.pm * BM + wr * 64 + (lane >> 3)) * ldc + colt + wc * 64 + 8 * (lane & 7);
#pragma unroll
        for (int ai = 0; ai < 2; ++ai)
#pragma unroll
            for (int m = 0; m < 4; ++m) {
#pragma unroll
                for (int bj = 0; bj < 2; ++bj) { f32x4 v0 = acc[ai][bj][m][0], v1 = acc[ai][bj][m][1];
                    if constexpr (!KPERM) { v0 = v0 * rs[ai][m]; v1 = v1 * rs[ai][m]; } else { v0 = v0 * cs[bj][0]; v1 = v1 * cs[bj][1]; }
                    u32x4 w; w.x = pk_bf16(v0[0], v0[1]); w.y = pk_bf16(v0[2], v0[3]); w.z = pk_bf16(v1[0], v1[1]); w.w = pk_bf16(v1[2], v1[3]);
                    *(PG8_LAS u32x4*)(wp + bj * 64) = w; }
                asm volatile("s_waitcnt lgkmcnt(0)" ::: "memory");
                const u32x4 o0 = *(const PG8_LAS u32x4*)rp, o1 = *(const PG8_LAS u32x4*)(rp + 8 * 144);
                asm volatile("s_waitcnt lgkmcnt(0)" ::: "memory");
                bf16_t* g0 = gp + (size_t)(ai * HALF + m * 16) * ldc;
                __builtin_nontemporal_store(o0, (u32x4*)g0); __builtin_nontemporal_store(o1, (u32x4*)(g0 + (size_t)8 * ldc));
            }
    }
};
typedef EpiBf16T<false> EpiBf16;
typedef EpiBf16T<true> EpiBf16K;
struct EpiSwiglu {
    static constexpr bool PERM = true, AFTER_DRAIN = false, WIDE = false;
    static __host__ __device__ __forceinline__ int permf(int rho) { return perm32(rho); }
    bf16_t* O; int ldc; const u64* ssq;
    __device__ __forceinline__ void prestage(PG8_LAS unsigned char* lds, const Unit& u, int par, int wid, int lane) const {
        if (wid < 2) { const int t0 = u.pm * BM + 128 * wid;
            __builtin_amdgcn_global_load_lds((const unsigned*)(ssq + t0 + 2 * lane), (PG8_LAS unsigned*)(lds + SIDE_OFF + par * SIDE_BYTES + wid * 1024), 16, 0, 0); }
    }
    __device__ __forceinline__ void operator()(const f32x4 (&acc)[2][2][4][2], const Unit& u, int wr, int wc, int fr, int fq, const PG8_LAS unsigned char* side, PG8_LAS unsigned char*, int) const {
        const int row0 = u.pm * BM + wr * 64 + fr; const int col0 = u.pn * HALF + wc * 32 + 8 * fq;
        const PG8_LAS u64* sq = (const PG8_LAS u64*)side;
#pragma unroll
        for (int ai = 0; ai < 2; ++ai)
#pragma unroll
            for (int m = 0; m < 4; ++m) { const int row = row0 + ai * HALF + m * 16; bf16_t* rowp = O + (size_t)row * ldc + col0;
                const float rs = rstd_of(sq[wr * 64 + fr + ai * HALF + m * 16]);
                float o[8];
#pragma unroll
                for (int n = 0; n < 2; ++n)
#pragma unroll
                    for (int e = 0; e < 4; ++e) { const float g = acc[ai][0][m][n][e] * rs, up = acc[ai][1][m][n][e] * rs;
                        o[4 * n + e] = g * fast_rcp(1.0f + fast_exp2(-g * LOG2E)) * up; }
                u32x4 w; w.x = pk_bf16(o[0], o[1]); w.y = pk_bf16(o[2], o[3]); w.z = pk_bf16(o[4], o[5]); w.w = pk_bf16(o[6], o[7]);
                __builtin_nontemporal_store(w, (u32x4*)rowp); }
    }
};
struct EpiRes {
    static constexpr bool PERM = true, AFTER_DRAIN = false, WIDE = true;
    static __host__ __device__ __forceinline__ int permf(int rho) { return perm32(rho); }
    bf16_t* H; u64* ssq_out;
    __device__ __forceinline__ void prestage(PG8_LAS unsigned char*, const Unit&, int, int, int) const {}
    __device__ __forceinline__ void operator()(const f32x4 (&acc)[2][2][4][2], const Unit& u, int wr, int wc, int fr, int fq, const PG8_LAS unsigned char*, PG8_LAS unsigned char* tl, int lane) const {
        const int row0 = u.pm * BM + wr * 64 + fr, col0 = u.pn * BM + wc * 64 + 8 * fq;
        PG8_LAS unsigned char* ap = tl + fr * 144 + fq * 16;
        const PG8_LAS unsigned char* rp = tl + (lane >> 3) * 144 + (lane & 7) * 16;
        bf16_t* gp = H + (size_t)(u.pm * BM + wr * 64 + (lane >> 3)) * D + u.pn * BM + wc * 64 + 8 * (lane & 7);
#pragma unroll
        for (int ai = 0; ai < 2; ++ai) {
            u32x4 hv8[4][2];
#pragma unroll
            for (int m = 0; m < 4; ++m)
#pragma unroll
                for (int bj = 0; bj < 2; ++bj) hv8[m][bj] = *(const u32x4*)(H + (size_t)(row0 + ai * HALF + m * 16) * D + col0 + bj * 32);
#pragma unroll
            for (int m = 0; m < 4; ++m) { const int row = row0 + ai * HALF + m * 16; float part = 0.f;
#pragma unroll
                for (int bj = 0; bj < 2; ++bj) { const u32x4 hv = hv8[m][bj];
                    const f32x4 a0 = acc[ai][bj][m][0], a1 = acc[ai][bj][m][1];
                    const float y0 = a0[0] + bf_lo(hv.x), y1 = a0[1] + bf_hi(hv.x), y2 = a0[2] + bf_lo(hv.y), y3 = a0[3] + bf_hi(hv.y);
                    const float y4 = a1[0] + bf_lo(hv.z), y5 = a1[1] + bf_hi(hv.z), y6 = a1[2] + bf_lo(hv.w), y7 = a1[3] + bf_hi(hv.w);
                    part += ((y0 * y0 + y1 * y1) + (y2 * y2 + y3 * y3)) + ((y4 * y4 + y5 * y5) + (y6 * y6 + y7 * y7));
                    u32x4 w; w.x = pk_bf16(y0, y1); w.y = pk_bf16(y2, y3); w.z = pk_bf16(y4, y5); w.w = pk_bf16(y6, y7);
                    *(PG8_LAS u32x4*)(ap + bj * 64) = w; }
                asm volatile("s_waitcnt lgkmcnt(0)" ::: "memory");
                const u32x4 o0 = *(const PG8_LAS u32x4*)rp, o1 = *(const PG8_LAS u32x4*)(rp + 8 * 144);
                asm volatile("s_waitcnt lgkmcnt(0)" ::: "memory");
                bf16_t* g0 = gp + (size_t)(ai * HALF + m * 16) * D;
                *(u32x4*)g0 = o0; *(u32x4*)(g0 + (size_t)8 * D) = o1;
                part += __shfl_xor(part, 16); part += __shfl_xor(part, 32);
                if (fq == 0) atomicAdd(ssq_out + row, (u64)(part * SSQ_FIX)); }
        }
    }
};

template <class Epi, class Sched, bool ALIGN_EPI = false, bool SP2 = false>
__device__ __forceinline__ void gemm_phase(PG8_LAS unsigned char* lds, const Gemm g, const Sched& S, const Epi& E) {
    int tid_ = threadIdx.x; asm volatile("" : "+v"(tid_));
    const int tid = tid_, wid = __builtin_amdgcn_readfirstlane(tid >> 6), lane = tid & 63, wr = wid >> 2, wc = wid & 3, fr = lane & 15, fq = lane >> 4;
    const int K = g.K, nt = K / BK;
    unsigned voffA[2], voffB[2];
#pragma unroll
    for (int i = 0; i < 2; ++i) { int R, C; stage_rc(tid * 16 + i * 8192, R, C); const int Rb = Epi::WIDE ? (64 * (R >> 5) + Epi::permf(R & 31)) : (Epi::PERM ? ((R & ~31) + Epi::permf(R & 31)) : R);
        voffA[i] = (unsigned)(R * K + C) * 2u; voffB[i] = (unsigned)(Rb * K + C) * 2u; }
    const size_t kstep = (size_t)(BK * 2);
    const size_t hstep = (size_t)HALF * K * 2;
    const size_t hstepB = Epi::WIDE ? (size_t)32 * K * 2 : hstep;
    const size_t tstep = 2 * hstep;
    const unsigned ldsw = (unsigned)wid * 1024u;
    const int aoff = lds_byte(wr * 64 + fr, fq * 8), boff = lds_byte(wc * 32 + fr, fq * 8);
#define PG8_SA(b, h) (((b) * 2 + (h)) * HTB)
#define PG8_SB(b, h) ((4 + (b) * 2 + (h)) * HTB)
#define PG8_STAGE(bufoff, gbase, voff) do { _Pragma("unroll") for (int _i = 0; _i < 2; ++_i) \
        __builtin_amdgcn_global_load_lds((const unsigned*)((const char*)(gbase) + (voff)[_i]), (PG8_LAS unsigned*)(lds + (bufoff) + ldsw + _i * 8192), 16, 0, 0); } while (0)
#define PG8_LDA(dst, b, h) do { _Pragma("unroll") for (int m = 0; m < 4; ++m) _Pragma("unroll") for (int k = 0; k < 2; ++k) dst[m][k] = *(const PG8_LAS bf16x8*)(lds + PG8_SA(b, h) + aoff + m * 2048 + k * 1024); } while (0)
#define PG8_LDB(dst, b, h) do { _Pragma("unroll") for (int n = 0; n < 2; ++n) _Pragma("unroll") for (int k = 0; k < 2; ++k) dst[n][k] = *(const PG8_LAS bf16x8*)(lds + PG8_SB(b, h) + boff + n * 2048 + k * 1024); } while (0)
#define PG8_MMA(ai, bj, At, Bt) do { __builtin_amdgcn_s_setprio(1); _Pragma("unroll") for (int m = 0; m < 4; ++m) _Pragma("unroll") for (int n = 0; n < 2; ++n) _Pragma("unroll") for (int k = 0; k < 2; ++k) \
        acc[ai][bj][m][n] = __builtin_amdgcn_mfma_f32_16x16x32_bf16(Bt[n][k], At[m][k], acc[ai][bj][m][n], 0, 0, 0); __builtin_amdgcn_s_setprio(0); } while (0)
#define PG8_WAIT_V(n) asm volatile("s_waitcnt vmcnt(" #n ")" ::: "memory")
#define PG8_WAIT_L(n) asm volatile("s_waitcnt lgkmcnt(" #n ")" ::: "memory")
#define PG8_BAR __builtin_amdgcn_s_barrier()
#define PG8_SCHED __builtin_amdgcn_sched_barrier(0)
    Unit cur, nxt; int ui = 0;
    if (!S.next(0, cur)) return;
    f32x4 acc[2][2][4][2];
#pragma unroll
    for (int a = 0; a < 2; ++a)
#pragma unroll
        for (int b = 0; b < 2; ++b)
#pragma unroll
            for (int m = 0; m < 4; ++m)
#pragma unroll
                for (int n = 0; n < 2; ++n) acc[a][b][m][n] = (f32x4){0.f, 0.f, 0.f, 0.f};
    bf16x8 At[4][2], B0[2][2], B1[2][2];
    const char* cA = (const char*)g.A + (size_t)cur.pm * tstep; const char* cB = (const char*)g.Bt + (size_t)cur.pn * tstep;
    S.a_ready(cur);
    if constexpr (SP2) {
        PG8_STAGE(PG8_SB(0, 0), cB, voffB); PG8_STAGE(PG8_SB(0, 1), cB + hstepB, voffB); PG8_STAGE(PG8_SA(0, 0), cA, voffA); PG8_STAGE(PG8_SA(0, 1), cA + hstep, voffA);
        if (wr == 1) PG8_BAR;
        PG8_WAIT_V(2); PG8_BAR;
        PG8_STAGE(PG8_SB(1, 0), cB + kstep, voffB); PG8_STAGE(PG8_SA(1, 0), cA + kstep, voffA); PG8_STAGE(PG8_SB(1, 1), cB + hstepB + kstep, voffB);
        PG8_WAIT_V(6); PG8_BAR;
    } else {
        PG8_STAGE(PG8_SB(0, 0), cB, voffB); PG8_STAGE(PG8_SA(0, 0), cA, voffA); PG8_STAGE(PG8_SB(0, 1), cB + hstepB, voffB); PG8_STAGE(PG8_SA(0, 1), cA + hstep, voffA);
        if (wr == 1) PG8_BAR;
        PG8_WAIT_V(4); PG8_BAR;
        PG8_STAGE(PG8_SB(1, 0), cB + kstep, voffB); PG8_STAGE(PG8_SA(1, 0), cA + kstep, voffA); PG8_STAGE(PG8_SB(1, 1), cB + hstepB + kstep, voffB);
        PG8_WAIT_V(6); PG8_BAR;
    }
    for (;;) {
        const bool has_next = S.next(ui + 1, nxt);
        const char* nA = has_next ? (const char*)g.A + (size_t)nxt.pm * tstep : cA; const char* nB = has_next ? (const char*)g.Bt + (size_t)nxt.pn * tstep : cB;
        E.prestage(lds, cur, ui & 1, wid, lane);
        for (int t = 0; t < nt; t += 2) {
            const bool last = (t == nt - 2);
            const char* a1 = cA + (size_t)(t + 1) * kstep;
            const char* a2 = last ? nA : cA + (size_t)(t + 2) * kstep; const char* b2 = last ? nB : cB + (size_t)(t + 2) * kstep;
            const char* a3 = a2 + kstep; const char* b3 = b2 + kstep;
            if (last && has_next) S.a_ready(nxt);
            if constexpr (SP2) {
            PG8_LDB(B0, 0, 0); PG8_LDB(B1, 0, 1); PG8_SCHED; PG8_LDA(At, 0, 0); PG8_STAGE(PG8_SA(1, 1), a1 + hstep, voffA);
            PG8_WAIT_V(8); PG8_WAIT_L(0); PG8_BAR; PG8_MMA(0, 0, At, B0); PG8_MMA(0, 1, At, B1); PG8_BAR; PG8_SCHED;
            PG8_LDA(At, 0, 1); PG8_STAGE(PG8_SB(0, 0), b2, voffB); PG8_STAGE(PG8_SB(0, 1), b2 + hstepB, voffB); PG8_STAGE(PG8_SA(0, 0), a2, voffA);
            PG8_WAIT_V(8); PG8_WAIT_L(0); PG8_BAR; PG8_MMA(1, 0, At, B0); PG8_MMA(1, 1, At, B1); PG8_BAR; PG8_SCHED;
            PG8_LDB(B0, 1, 0); PG8_LDB(B1, 1, 1); PG8_SCHED; PG8_LDA(At, 1, 0); PG8_STAGE(PG8_SA(0, 1), a2 + hstep, voffA);
            PG8_WAIT_V(8); PG8_WAIT_L(0); PG8_BAR; PG8_MMA(0, 0, At, B0); PG8_MMA(0, 1, At, B1); PG8_BAR; PG8_SCHED;
            PG8_LDA(At, 1, 1); PG8_STAGE(PG8_SB(1, 0), b3, voffB); PG8_STAGE(PG8_SB(1, 1), b3 + hstepB, voffB); PG8_STAGE(PG8_SA(1, 0), a3, voffA);
            PG8_WAIT_V(8); PG8_WAIT_L(0); PG8_BAR; PG8_MMA(1, 0, At, B0); PG8_MMA(1, 1, At, B1); PG8_BAR; PG8_SCHED;
            } else {
            PG8_LDB(B0, 0, 0); PG8_SCHED; PG8_LDA(At, 0, 0); PG8_STAGE(PG8_SA(1, 1), a1 + hstep, voffA);
            PG8_WAIT_L(8); PG8_BAR; PG8_WAIT_L(0); PG8_MMA(0, 0, At, B0); PG8_BAR; PG8_SCHED;
            PG8_LDB(B1, 0, 1); PG8_STAGE(PG8_SB(0, 0), b2, voffB);
            PG8_BAR; PG8_WAIT_L(0); PG8_MMA(0, 1, At, B1); PG8_BAR;
            PG8_LDA(At, 0, 1); PG8_STAGE(PG8_SA(0, 0), a2, voffA);
            PG8_BAR; PG8_WAIT_L(0); PG8_MMA(1, 0, At, B0); PG8_BAR; PG8_SCHED;
            PG8_STAGE(PG8_SB(0, 1), b2 + hstepB, voffB);
            PG8_WAIT_V(6); PG8_BAR; PG8_MMA(1, 1, At, B1); PG8_BAR;
            PG8_LDB(B0, 1, 0); PG8_SCHED; PG8_LDA(At, 1, 0); PG8_STAGE(PG8_SA(0, 1), a2 + hstep, voffA);
            PG8_WAIT_L(8); PG8_BAR; PG8_WAIT_L(0); PG8_MMA(0, 0, At, B0); PG8_BAR; PG8_SCHED;
            PG8_LDB(B1, 1, 1); PG8_STAGE(PG8_SB(1, 0), b3, voffB);
            PG8_BAR; PG8_WAIT_L(0); PG8_MMA(0, 1, At, B1); PG8_BAR;
            PG8_LDA(At, 1, 1); PG8_STAGE(PG8_SA(1, 0), a3, voffA);
            PG8_BAR; PG8_WAIT_L(0); PG8_MMA(1, 0, At, B0); PG8_BAR; PG8_SCHED;
            PG8_STAGE(PG8_SB(1, 1), b3 + hstepB, voffB);
            PG8_WAIT_V(6); PG8_BAR; PG8_MMA(1, 1, At, B1); PG8_BAR;
            }
        }
        if constexpr (ALIGN_EPI) { if (wr == 0) PG8_BAR; }
        if constexpr (!Epi::AFTER_DRAIN) { E(acc, cur, wr, wc, fr, fq, lds + SIDE_OFF + (ui & 1) * SIDE_BYTES, lds + EPI_T_OFF + wid * EPI_T_WAVE, lane); S.done(cur); }
        if (!has_next) break;
#pragma unroll
        for (int a = 0; a < 2; ++a)
#pragma unroll
            for (int b = 0; b < 2; ++b)
#pragma unroll
                for (int m = 0; m < 4; ++m)
#pragma unroll
                    for (int n = 0; n < 2; ++n) acc[a][b][m][n] = (f32x4){0.f, 0.f, 0.f, 0.f};
        cur = nxt; cA = nA; cB = nB; ++ui;
        if constexpr (ALIGN_EPI) { if (wr == 1) PG8_BAR; }
    }
    PG8_WAIT_V(0);
    if constexpr (!ALIGN_EPI) { if (wr == 0) PG8_BAR; }
    PG8_BAR;
#undef PG8_SA
#undef PG8_SB
#undef PG8_STAGE
#undef PG8_LDA
#undef PG8_LDB
#undef PG8_MMA
#undef PG8_WAIT_V
#undef PG8_WAIT_L
#undef PG8_BAR
#undef PG8_SCHED
}
}

constexpr size_t MiB = 1u << 20;
constexpr size_t WS_CTL = 0, CTL_ZERO_BYTES = 6 * MiB;
constexpr size_t WS_SSQ = 1 * MiB, SSQ_STRIDE = (size_t)M * 8;
constexpr size_t WS_WA = 6 * MiB;
constexpr size_t WA_STRIDE = 10 * MiB, WA_QKO = 0, WA_KV = 4 * MiB, WA_G = 7 * MiB, WA_OUT = 8 * MiB;
constexpr size_t WS_WQK2 = 26 * MiB;
constexpr size_t WS_WQ3 = 30 * MiB;
constexpr size_t WS_WV = 32 * MiB;
constexpr size_t WS_WO = 34 * MiB;
constexpr size_t WS_WF = 38 * MiB;
constexpr size_t WF_STRIDE = 17 * MiB, WF_D = 11 * MiB;
constexpr size_t WS_GATES = 106 * MiB;
constexpr size_t WS_XN = 110 * MiB;
constexpr size_t WS_H = 238 * MiB;
constexpr size_t WS_BIG = 366 * MiB;
constexpr size_t WS_KVT = WS_BIG + 256 * MiB;
constexpr size_t WS_END = WS_KVT + 192 * MiB;
static_assert(WS_SSQ + 9 * SSQ_STRIDE <= CTL_ZERO_BYTES && WS_WF + 4 * WF_STRIDE <= WS_GATES && WS_GATES + (size_t)M * 16 * 4 <= WS_XN && WS_XN + (size_t)M * D * 2 <= WS_H && WS_H + (size_t)M * D * 2 <= WS_BIG, "ws map");
static_assert(WS_BIG + (size_t)M * FF * 2 <= WS_END, "ws map");

constexpr int CW_BAR = 4096;
constexpr int RING_BYTES = 131072;
constexpr int LDSCTL_OFF = RING_BYTES, MISC_OFF = LDSCTL_OFF + 320;
constexpr int LDS_BYTES = 163840;
constexpr int NWAVES = 8;

#define XB_TMO      128
#define XB_XCNT(j)  (256  + 64 * (j))
#define XB_XSUB(j)  (1280 + 64 * (j))
#define XB_XGEN(j)  (2304 + 64 * (j))
#define XB_TOP      3328
#define XB_TOPGEN   3392
#define XCD_BAR_WORDS 3456
#define XB_SPIN_CAP (1u << 18)

__device__ __forceinline__ unsigned xb_ld(unsigned* p)              { return __hip_atomic_load(p, __ATOMIC_RELAXED, __HIP_MEMORY_SCOPE_AGENT); }
__device__ __forceinline__ unsigned xb_add(unsigned* p, unsigned v) { return __hip_atomic_fetch_add(p, v, __ATOMIC_RELAXED, __HIP_MEMORY_SCOPE_AGENT); }
__device__ __forceinline__ unsigned xb_xcc_id() { return (unsigned)__builtin_amdgcn_s_getreg((3 << 11) | 20) & 0xFu; }
#define XB_SPIN(cond, bar) do { unsigned _sp = 0; while (cond) { __builtin_amdgcn_s_sleep(1); \
    if ((++_sp & 255u) == 0u) { if (xb_ld(&(bar)[XB_TMO])) break; if (_sp > XB_SPIN_CAP) { atomicAdd(&(bar)[XB_TMO], 1u); break; } } } } while (0)

struct XcdBarrier { unsigned* bar; unsigned x; volatile LAS unsigned* st; };

__device__ __forceinline__ XcdBarrier xcd_barrier_post(unsigned* bar, volatile LAS unsigned* st) {
    XcdBarrier b; b.bar = bar; b.x = xb_xcc_id(); b.st = st;
    if (threadIdx.x == 0) (void)xb_add(&bar[XB_XCNT(b.x)], 1u);
    return b;
}
__device__ __forceinline__ void xcd_barrier_complete(unsigned* bar, unsigned x, unsigned& nloc, unsigned& nx) {
    const unsigned G = gridDim.x * gridDim.y * gridDim.z;
    unsigned sum, cnt, mine, sp = 0u;
    for (;;) {
        sum = 0u; cnt = 0u; mine = 0u;
#pragma unroll
        for (unsigned j = 0; j < 16; ++j) { const unsigned c = xb_ld(&bar[XB_XCNT(j)]); sum += c; cnt += (c > 0u) ? 1u : 0u; mine = (j == x) ? c : mine; }
        if (sum == G) break;
        __builtin_amdgcn_s_sleep(1);
        if ((++sp & 255u) == 0u) { if (xb_ld(&bar[XB_TMO])) break; if (sp > XB_SPIN_CAP) { atomicAdd(&bar[XB_TMO], 1u); break; } }
    }
    nloc = mine > 0u ? mine : 1u; nx = cnt > 0u ? cnt : 1u;
}
__device__ __forceinline__ void xcd_barrier(const XcdBarrier& b) {
    asm volatile("s_waitcnt vmcnt(0)" ::: "memory");
    __syncthreads();
    if (threadIdx.x == 0) {
        unsigned* bar = b.bar;
        __builtin_amdgcn_s_waitcnt(0);
        unsigned nloc = b.st[0], nx = b.st[1];
        if (nloc == 0u) { xcd_barrier_complete(bar, b.x, nloc, nx); b.st[0] = nloc; b.st[1] = nx; }
        const unsigned old = xb_add(&bar[XB_XSUB(b.x)], 1u);
        const unsigned gen = old / nloc;
        if (old + 1u == (gen + 1u) * nloc) {
            __builtin_amdgcn_fence(__ATOMIC_RELEASE, "agent");
            asm volatile("s_waitcnt vmcnt(0)" ::: "memory");
            const unsigned og = xb_add(&bar[XB_TOP], 1u);
            const unsigned tg = og / nx;
            if (og + 1u == (tg + 1u) * nx) xb_add(&bar[XB_TOPGEN], 1u);
            else XB_SPIN(xb_ld(&bar[XB_TOPGEN]) == tg, bar);
            __builtin_amdgcn_fence(__ATOMIC_ACQUIRE, "agent");
            xb_add(&bar[XB_XGEN(b.x)], 1u);
            asm volatile("s_waitcnt vmcnt(0)" ::: "memory");
        } else {
            XB_SPIN(xb_ld(&bar[XB_XGEN(b.x)]) == gen, bar);
            __builtin_amdgcn_fence(__ATOMIC_ACQUIRE, "agent");
            asm volatile("s_waitcnt vmcnt(0)" ::: "memory");
        }
    }
    __syncthreads();
}

#define LDS_WAIT() asm volatile("s_waitcnt lgkmcnt(0)" ::: "memory")
__device__ __forceinline__ float wave_sum(float v) {
#pragma unroll
    for (int o = 1; o < 64; o <<= 1) v += __shfl_xor(v, o);
    return v;
}
__device__ __forceinline__ float xhalf_max(float x) { const auto r = __builtin_amdgcn_permlane32_swap(__float_as_uint(x), __float_as_uint(x), false, false); return fmaxf(__uint_as_float(r[0]), __uint_as_float(r[1])); }
__device__ __forceinline__ float xhalf_sum(float x) { const auto r = __builtin_amdgcn_permlane32_swap(__float_as_uint(x), __float_as_uint(x), false, false); return __uint_as_float(r[0]) + __uint_as_float(r[1]); }
__device__ __forceinline__ int crow(int reg, int hh) { return (reg & 3) + 8 * (reg >> 2) + 4 * hh; }
__device__ __forceinline__ f32x16 mfma32(bf16x8 a, bf16x8 b, f32x16 c) { return __builtin_amdgcn_mfma_f32_32x32x16_bf16(a, b, c, 0, 0, 0); }
__device__ __forceinline__ f32x16 zero16() { f32x16 z;
#pragma unroll
    for (int i = 0; i < 16; ++i) z[i] = 0.f;
    return z; }
__device__ __forceinline__ bf16x8 pack8(const f32x16& x, int s) {
    u32x4 p; p.x = pk_bf16(x[8 * s + 0], x[8 * s + 1]); p.y = pk_bf16(x[8 * s + 2], x[8 * s + 3]); p.z = pk_bf16(x[8 * s + 4], x[8 * s + 5]); p.w = pk_bf16(x[8 * s + 6], x[8 * s + 7]);
    return __builtin_bit_cast(bf16x8, p);
}
__device__ __forceinline__ bf16x8 ldperm(const bf16* p) {
    const u32x2 lo = *(const u32x2*)p, hi = *(const u32x2*)(p + 8);
    u32x4 v; v.x = lo.x; v.y = lo.y; v.z = hi.x; v.w = hi.y; return __builtin_bit_cast(bf16x8, v);
}
__device__ __forceinline__ bf16x8 ldnat(const bf16* p) { return __builtin_bit_cast(bf16x8, *(const u32x4*)p); }

struct Args { const float* in[16]; float* out; unsigned char* ws; int ph_lo, ph_hi; };
enum { I_X = 0, I_AWIN, I_ABG, I_AGH, I_AWOUT, I_BWQ, I_BREL, I_BWO, I_KVG, I_WKV, I_NMIX, I_NFFN, I_FG, I_FU, I_FD, I_FING };

struct Frame {
    LAS unsigned char* lds;
    int tid, lane, wave, G, bx;
};

struct Job { const float* src; int ldw, K, col0, ncol; bf16* dst; int drow0, inter, dperm; const float* gain; float scale; };
constexpr int NJOBS = 30;
constexpr float QSCALE = 0.125f * LOG2E;
__device__ __forceinline__ Job make_job(const Args& A, int j) {
    Job o; unsigned char* ws = A.ws;
    o.inter = -1; o.dperm = 0; o.gain = nullptr; o.scale = 1.f; o.ldw = D; o.K = D; o.col0 = 0; o.ncol = D; o.drow0 = 0; o.src = nullptr; o.dst = nullptr;
    if (j < 12) {
        const int l = j / 6, t = j % 6;
        unsigned char* wb = ws + WS_WA + (size_t)l * WA_STRIDE;
        if (t < 5) {
            o.src = A.in[I_AWIN] + (size_t)l * D * AIN; o.ldw = AIN; o.gain = A.in[I_NMIX] + l * D;
            if (t == 0) { o.col0 = 0; o.ncol = 512; o.dst = (bf16*)(wb + WA_QKO); o.drow0 = 0; }
            else if (t == 1) { o.col0 = 512; o.ncol = 512; o.dst = (bf16*)(wb + WA_QKO); o.drow0 = 512; o.scale = 0.125f; }
            else if (t == 2) { o.col0 = 2048; o.ncol = 1024; o.dst = (bf16*)(wb + WA_QKO); o.drow0 = 1024; }
            else if (t == 3) { o.col0 = 512; o.ncol = 0; o.dst = (bf16*)(wb + WA_KV); o.drow0 = 0; }
            else { o.col0 = 1024; o.ncol = 1024; o.dst = (bf16*)(wb + WA_KV); o.drow0 = 0; }
        } else { o.src = A.in[I_AWOUT] + (size_t)l * D * D; o.dst = (bf16*)(wb + WA_OUT); }
    } else if (j < 18) {
        const int t = j - 12;
        if (t == 0) { o.src = A.in[I_BWQ]; o.dst = (bf16*)(ws + WS_WQK2); o.gain = A.in[I_NMIX] + 2 * D; o.scale = QSCALE; }
        else if (t == 1) { o.src = A.in[I_WKV]; o.ldw = 2 * D; o.col0 = 0; o.dst = (bf16*)(ws + WS_WQK2); o.drow0 = 1024; o.gain = A.in[I_KVG]; }
        else if (t == 2) { o.src = A.in[I_WKV]; o.ldw = 2 * D; o.col0 = 1024; o.dst = (bf16*)(ws + WS_WV); o.gain = A.in[I_KVG]; }
        else if (t == 3) { o.src = A.in[I_BWQ] + (size_t)D * D; o.dst = (bf16*)(ws + WS_WQ3); o.gain = A.in[I_NMIX] + 3 * D; o.scale = QSCALE; }
        else if (t == 4) { o.src = A.in[I_BWO]; o.dst = (bf16*)(ws + WS_WO); }
        else { o.src = A.in[I_BWO] + (size_t)D * D; o.dst = (bf16*)(ws + WS_WO + 2 * MiB); }
    } else {
        const int l = (j - 18) / 3, t = (j - 18) % 3;
        unsigned char* wb = ws + WS_WF + (size_t)l * WF_STRIDE;
        if (t == 0) { o.src = A.in[I_FG] + (size_t)l * D * FF; o.ldw = FF; o.ncol = FF; o.dst = (bf16*)wb; o.inter = 0; o.gain = A.in[I_NFFN] + l * D; }
        else if (t == 1) { o.src = A.in[I_FU] + (size_t)l * D * FF; o.ldw = FF; o.ncol = FF; o.dst = (bf16*)wb; o.inter = 1; o.gain = A.in[I_NFFN] + l * D; }
        else { o.src = A.in[I_FD] + (size_t)l * FF * D; o.ldw = D; o.K = FF; o.ncol = D; o.dst = (bf16*)(wb + WF_D); }
    }
    return o;
}
__device__ __forceinline__ void p0_transpose_item(const Job& jb, LAS float* scr, int item, int lane) {
    const int nblk = jb.ncol / 32, kb = item / nblk, nb = item % nblk, k0 = 64 * kb, n0 = 32 * nb;
    const float* W = jb.src + jb.col0 + n0;
    f32x4 wv[8];
#pragma unroll
    for (int i = 0; i < 8; ++i) wv[i] = __builtin_nontemporal_load((const f32x4*)(W + (size_t)(k0 + 8 * i + (lane >> 3)) * jb.ldw + 4 * (lane & 7)));
#pragma unroll
    for (int i = 0; i < 8; ++i) { const int kk = 8 * i + (lane >> 3); const float gg = (jb.gain ? jb.gain[k0 + kk] : 1.f) * jb.scale; LAS float* d = scr + kk * 33 + 4 * (lane & 7);
        d[0] = wv[i].x * gg; d[1] = wv[i].y * gg; d[2] = wv[i].z * gg; d[3] = wv[i].w * gg; }
    LDS_WAIT(); asm volatile("" ::: "memory");
    const int c = lane & 7;
    const int drow = jb.drow0 + (jb.inter >= 0 ? 256 * (n0 >> 7) + 128 * jb.inter + (n0 & 127) : n0);
#pragma unroll
    for (int j = 0; j < 4; ++j) { const int n = (lane >> 3) + 8 * j; const LAS float* s = scr + (8 * c) * 33 + n;
        const int nd = jb.dperm ? ((n & ~15) | ((n & 3) | ((n & 4) << 1) | ((n & 8) >> 1))) : n;
        u32x4 o; o.x = pk_bf16(s[0 * 33], s[1 * 33]); o.y = pk_bf16(s[2 * 33], s[3 * 33]); o.z = pk_bf16(s[4 * 33], s[5 * 33]); o.w = pk_bf16(s[6 * 33], s[7 * 33]);
        *(u32x4*)(jb.dst + (size_t)(drow + nd) * jb.K + k0 + 8 * c) = o; }
    LDS_WAIT(); asm volatile("" ::: "memory");
}
__device__ __forceinline__ void p0_prologue(const Frame& F, const Args& A) {
    LAS float* scr = (LAS float*)(F.lds + F.wave * 16384);
    const int gw = F.bx * NWAVES + F.wave, NGW = F.G * NWAVES;
    int off = 0;
    for (int j = 0; j < NJOBS; ++j) {
        const Job jb = make_job(A, j);
        const int n = (jb.K / 64) * (jb.ncol / 32);
        int first = (gw - off) % NGW; if (first < 0) first += NGW;
        for (int r = first; r < n; r += NGW) p0_transpose_item(jb, scr, r, F.lane);
        off += n;
    }
    for (int e = (F.bx * NWAVES * 64 + F.tid); e < 2 * 16 * D; e += F.G * NWAVES * 64) {
        const int l = e / (16 * D), j = (e / D) % 16, k = e % D;
        const float w = A.in[I_AWIN][(size_t)l * D * AIN + (size_t)k * AIN + 3072 + j] * A.in[I_NMIX][l * D + k];
        ((bf16*)(A.ws + WS_WA + (size_t)l * WA_STRIDE + WA_G))[j * D + k] = (bf16)(pk_bf16(w, 0.f) & 0xffffu);
    }
}

__device__ __forceinline__ void xconv_phase(const Frame& F, const float* x, bf16* h, u64* ssq) {
    const int gw = F.bx * NWAVES + F.wave, NGW = F.G * NWAVES;
    for (int m = gw; m < M; m += NGW) {
        const f32x4* xr = (const f32x4*)(x + (size_t)m * D) + F.lane;
        f32x4 v[4]; float s = 0.f;
#pragma unroll
        for (int j = 0; j < 4; ++j) { v[j] = __builtin_nontemporal_load(xr + 64 * j); s += (v[j].x * v[j].x + v[j].y * v[j].y) + (v[j].z * v[j].z + v[j].w * v[j].w); }
        s = wave_sum(s);
        if (F.lane == 0) ssq[m] = (u64)(s * SSQ_FIX);
        u32x2* o8 = (u32x2*)(h + (size_t)m * D) + F.lane;
#pragma unroll
        for (int j = 0; j < 4; ++j) { u32x2 w; w.x = pk_bf16(v[j].x, v[j].y); w.y = pk_bf16(v[j].z, v[j].w); o8[64 * j] = w; }
    }
}
__device__ __forceinline__ void final_norm_phase(const Frame& F, const bf16* h, const u64* ssq, const float* g, float* out) {
    const int gw = F.bx * NWAVES + F.wave, NGW = F.G * NWAVES;
    f32x4 gv[4];
#pragma unroll
    for (int j = 0; j < 2; ++j) { gv[2 * j] = *(const f32x4*)(g + 512 * j + 8 * F.lane); gv[2 * j + 1] = *(const f32x4*)(g + 512 * j + 8 * F.lane + 4); }
    for (int m = gw; m < M; m += NGW) {
        const bf16* hr = h + (size_t)m * D + 8 * F.lane;
        const u32x4 h0 = __builtin_nontemporal_load((const u32x4*)hr), h1 = __builtin_nontemporal_load((const u32x4*)(hr + 512));
        const float rstd = 1.f / sqrtf((float)ssq[m] * (1.0f / (1048576.0f * 1024.0f)) + EPS);
        float* orow = out + (size_t)m * D + 8 * F.lane;
        f32x4 v;
        v.x = bf_lo(h0.x); v.y = bf_hi(h0.x); v.z = bf_lo(h0.y); v.w = bf_hi(h0.y); __builtin_nontemporal_store(v * rstd * gv[0], (f32x4*)(orow));
        v.x = bf_lo(h0.z); v.y = bf_hi(h0.z); v.z = bf_lo(h0.w); v.w = bf_hi(h0.w); __builtin_nontemporal_store(v * rstd * gv[1], (f32x4*)(orow + 4));
        v.x = bf_lo(h1.x); v.y = bf_hi(h1.x); v.z = bf_lo(h1.y); v.w = bf_hi(h1.y); __builtin_nontemporal_store(v * rstd * gv[2], (f32x4*)(orow + 512));
        v.x = bf_lo(h1.z); v.y = bf_hi(h1.z); v.z = bf_lo(h1.w); v.w = bf_hi(h1.w); __builtin_nontemporal_store(v * rstd * gv[3], (f32x4*)(orow + 516));
    }
}

__device__ __forceinline__ void gates_phase(const Frame& F, const bf16* h, const u64* ssq, const bf16* wg, const float* bgate, float* gt) {
    const int gw = F.bx * NWAVES + F.wave, NGW = F.G * NWAVES;
    int lane_ = F.lane; asm volatile("" : "+v"(lane_));
    const int r16 = lane_ & 15, kg = lane_ >> 4;
    const float bias = bgate[r16];
    for (int it = gw; it < M / 16; it += NGW) {
        const bf16* ap = h + (size_t)(it * 16 + r16) * D + 8 * kg;
        const bf16* bp = wg + (size_t)r16 * D + 8 * kg;
        f32x4 acc = {0.f, 0.f, 0.f, 0.f};
#pragma unroll 8
        for (int s = 0; s < D / 32; ++s) acc = __builtin_amdgcn_mfma_f32_16x16x32_bf16(ldnat(ap + 32 * s), ldnat(bp + 32 * s), acc, 0, 0, 0);
        f32x4 o;
#pragma unroll
        for (int e = 0; e < 4; ++e) o[e] = acc[e] * rstd_of(ssq[it * 16 + 4 * kg + e]) + bias;
        *(f32x4*)(gt + (size_t)r16 * M + it * 16 + 4 * kg) = o;
    }
}

typedef short v4i16_t __attribute__((ext_vector_type(4)));
constexpr int ML_Q = 0, ML_K = 8192, ML_VT = 16384, ML_OP = 32768, ML_BUF = 49152;
constexpr int ML_KS = 2 * ML_BUF, ML_SCR = ML_KS + 8192, ML_SSQ = ML_SCR + 8192;
constexpr int ML_OT = pg8::EPI_T_OFF;
static_assert(ML_SSQ + 2048 + 512 <= RING_BYTES && ML_OT + 8 * 32 * 80 <= 163840, "mLSTM LDS map");
__device__ __forceinline__ void mlstm_phase(const Frame& F, const bf16* qko, const bf16* vtg, const float* gates, const float* ghead, bf16* hs) {
    int lane_ = F.lane; asm volatile("" : "+v"(lane_));
    const int w = F.wave, lane = lane_, r = lane & 31, hh = lane >> 5, vblk = w & 3, tblk = w >> 2;
    LAS float* Gs = (LAS float*)(F.lds + ML_SCR + w * 1024);
    LAS float* WAs = Gs + 64;
    LAS float* SSQ = (LAS float*)(F.lds + ML_SSQ);
    const int xs = (r >> 1) & 7;
    const int foff0 = r * 128 + (((0 + hh) ^ xs) << 4), foff1 = r * 128 + (((2 + hh) ^ xs) << 4), foff2 = r * 128 + (((4 + hh) ^ xs) << 4), foff3 = r * 128 + (((6 + hh) ^ xs) << 4);
    const int qpo0 = r * 128 + 8 * hh;
    const int tq = (lane & 15) >> 2, tp = lane & 3, tg = (lane >> 4) & 1;
    const int t = 32 * tblk + r;
    const bf16x8 ONES = __builtin_bit_cast(bf16x8, (u32x4){0x3F803F80u, 0x3F803F80u, 0x3F803F80u, 0x3F803F80u});
#define ML_DMA(g_, off_) __builtin_amdgcn_global_load_lds((const unsigned*)(g_), (LAS unsigned*)(bufp + (off_)), 16, 0, 0)
#define ML_ISSUE(cc_) do { const size_t tk_ = (size_t)b * SEQ + (size_t)(cc_) * CH; LAS unsigned char* bufp = F.lds + ((cc_) & 1) * ML_BUF + w * 1024; \
        int l2_ = lane; asm volatile("" : "+v"(l2_));        \
        const int r8_ = 8 * w + (l2_ >> 3), c8_ = (l2_ & 7) ^ ((r8_ >> 1) & 7), r4a_ = 4 * w + (l2_ >> 4), c4a_ = (l2_ & 15) ^ (r4a_ & 15), r4b_ = r4a_ + 32, c4b_ = (l2_ & 15) ^ (r4b_ & 15); \
        ML_DMA(qko + (tk_ + r8_) * 2048 + h * DQK + c8_ * 8, ML_Q); \
        ML_DMA(qko + (tk_ + r8_) * 2048 + 512 + h * DQK + c8_ * 8, ML_K); \
        ML_DMA(vtg + (size_t)(h * DV + r8_) * M + tk_ + c8_ * 8, ML_VT); \
        ML_DMA(vtg + (size_t)(h * DV + 64 + r8_) * M + tk_ + c8_ * 8, ML_VT + 8192); \
        ML_DMA(qko + (tk_ + r4a_) * 2048 + 1024 + h * DV + c4a_ * 8, ML_OP); \
        ML_DMA(qko + (tk_ + r4b_) * 2048 + 1024 + h * DV + c4b_ * 8, ML_OP + 8192); } while (0)
#define ML_FRAG(off_) (*(const LAS bf16x8*)(buf + (off_)))
    for (int bh = F.bx; bh < NBATCH * AH; bh += F.G) {
        const int b = bh / AH, h = bh % AH;
        asm volatile("s_waitcnt vmcnt(0) lgkmcnt(0)" ::: "memory"); __builtin_amdgcn_s_barrier(); asm volatile("" ::: "memory");
        f32x16 Ct0 = zero16(), Ct1 = zero16(), Nt0 = zero16(), Nt1 = zero16();
        float m_state = -1e30f;
        LAS float* GH = (LAS float*)(F.lds + ML_SSQ + 2048);
        if (F.tid < DV) GH[F.tid] = ghead[h * DV + F.tid];
        const float* gi = gates + (size_t)h * M + (size_t)b * SEQ + lane; const float* gf = gates + (size_t)(8 + h) * M + (size_t)b * SEQ + lane;
        float ipre_n = gi[0], fpre_n = gf[0];
        ML_ISSUE(0);
        for (int c = 0; c < NCH; ++c) {
            const size_t tok0 = (size_t)b * SEQ + (size_t)c * CH;
            const LAS unsigned char* buf = F.lds + (c & 1) * ML_BUF;
            const float ipre = ipre_n * LOG2E, fpre = fpre_n;
            const float flog = (fminf(fpre, 0.f) - __logf(1.f + __expf(-fabsf(fpre)))) * LOG2E;
            float bc = flog;
#pragma unroll
            for (int o = 1; o < 64; o <<= 1) { const float tv = __shfl_up(bc, o); if (lane >= o) bc += tv; }
            const float gs = ipre - bc;
            float pm = gs;
#pragma unroll
            for (int o = 1; o < 64; o <<= 1) { const float tv = __shfl_up(pm, o); if (lane >= o) pm = fmaxf(pm, tv); }
            const float Mt = fmaxf(m_state, pm);
            const float bL = __shfl(bc, 63), M63 = __shfl(Mt, 63);
            const float wa = fast_exp2(gs - M63);
            const float decay = fast_exp2(m_state - M63);
            const float wint_l = fast_exp2(m_state - Mt), floor_l = fast_exp2(-bc - Mt);
            Gs[lane] = gs; WAs[lane] = wa;
            const float Mt_t = __shfl(Mt, t), wint = __shfl(wint_l, t), floorv = __shfl(floor_l, t);
            asm volatile("s_waitcnt vmcnt(0) lgkmcnt(0)" ::: "memory"); __builtin_amdgcn_s_barrier(); asm volatile("" ::: "memory");
            if (c + 1 < NCH) { ipre_n = gi[(c + 1) * CH]; fpre_n = gf[(c + 1) * CH]; ML_ISSUE(c + 1); }
            {
                const u32x4 kraw = *(const LAS u32x4*)(buf + ML_K + w * 1024 + lane * 16);
                const float was = WAs[8 * w + (lane >> 3)];
                u32x4 ko; ko.x = pk_bf16(bf_lo(kraw.x) * was, bf_hi(kraw.x) * was); ko.y = pk_bf16(bf_lo(kraw.y) * was, bf_hi(kraw.y) * was);
                ko.z = pk_bf16(bf_lo(kraw.z) * was, bf_hi(kraw.z) * was); ko.w = pk_bf16(bf_lo(kraw.w) * was, bf_hi(kraw.w) * was);
                *(LAS u32x4*)(F.lds + ML_KS + w * 1024 + lane * 16) = ko;
            }
            const bf16x8 qf0 = ML_FRAG(ML_Q + tblk * 4096 + foff0), qf1 = ML_FRAG(ML_Q + tblk * 4096 + foff1), qf2 = ML_FRAG(ML_Q + tblk * 4096 + foff2), qf3 = ML_FRAG(ML_Q + tblk * 4096 + foff3);
            f32x16 S0 = zero16(), S1 = zero16();
            S0 = mfma32(ML_FRAG(ML_K + foff0), qf0, S0); S0 = mfma32(ML_FRAG(ML_K + foff1), qf1, S0); S0 = mfma32(ML_FRAG(ML_K + foff2), qf2, S0); S0 = mfma32(ML_FRAG(ML_K + foff3), qf3, S0);
            if (tblk == 1) { S1 = mfma32(ML_FRAG(ML_K + 4096 + foff0), qf0, S1); S1 = mfma32(ML_FRAG(ML_K + 4096 + foff1), qf1, S1); S1 = mfma32(ML_FRAG(ML_K + 4096 + foff2), qf2, S1); S1 = mfma32(ML_FRAG(ML_K + 4096 + foff3), qf3, S1); }
            if (tblk == 0) {
#pragma unroll
                for (int g4 = 0; g4 < 4; ++g4) { const f32x4 ga = *(const LAS f32x4*)(Gs + 8 * g4 + 4 * hh);
#pragma unroll
                    for (int e = 0; e < 4; ++e) { const int s0 = 8 * g4 + 4 * hh + e; S0[4 * g4 + e] = (s0 <= t) ? S0[4 * g4 + e] * fast_exp2(ga[e] - Mt_t) : 0.f; } }
            } else {
#pragma unroll
                for (int g4 = 0; g4 < 4; ++g4) { const f32x4 ga = *(const LAS f32x4*)(Gs + 8 * g4 + 4 * hh); const f32x4 gb = *(const LAS f32x4*)(Gs + 32 + 8 * g4 + 4 * hh);
#pragma unroll
                    for (int e = 0; e < 4; ++e) { const int s1 = 32 + 8 * g4 + 4 * hh + e; S0[4 * g4 + e] = S0[4 * g4 + e] * fast_exp2(ga[e] - Mt_t);
                        S1[4 * g4 + e] = (s1 <= t) ? S1[4 * g4 + e] * fast_exp2(gb[e] - Mt_t) : 0.f; } }
            }
            const bf16x8 p0 = pack8(S0, 0), p1 = pack8(S0, 1), p2 = pack8(S1, 0), p3 = pack8(S1, 1);
            __builtin_amdgcn_sched_barrier(0);
            float den;
            { f32x16 accs = zero16();
              accs = mfma32(ONES, p0, accs); accs = mfma32(ONES, p1, accs);
              if (tblk == 1) { accs = mfma32(ONES, p2, accs); accs = mfma32(ONES, p3, accs); }
              den = accs[0]; }
            bf16x8 qp[4];
#pragma unroll
            for (int f = 0; f < 4; ++f) { const u32x2 lo = *(const LAS u32x2*)(buf + ML_Q + tblk * 4096 + qpo0 + (((2 * f) ^ xs) << 4)), hi = *(const LAS u32x2*)(buf + ML_Q + tblk * 4096 + qpo0 + (((2 * f + 1) ^ xs) << 4));
                u32x4 v; v.x = lo.x; v.y = lo.y; v.z = hi.x; v.w = hi.y; qp[f] = __builtin_bit_cast(bf16x8, v); }
            { f32x16 accd = zero16();
              accd = mfma32(pack8(Nt0, 0), qp[0], accd); accd = mfma32(pack8(Nt0, 1), qp[1], accd); accd = mfma32(pack8(Nt1, 0), qp[2], accd); accd = mfma32(pack8(Nt1, 1), qp[3], accd);
              den += accd[0] * wint; }
            __builtin_amdgcn_sched_barrier(0);
            f32x16 acc = zero16();
            acc = mfma32(pack8(Ct0, 0), qp[0], acc); acc = mfma32(pack8(Ct0, 1), qp[1], acc); acc = mfma32(pack8(Ct1, 0), qp[2], acc); acc = mfma32(pack8(Ct1, 1), qp[3], acc);
#pragma unroll
            for (int i = 0; i < 16; ++i) acc[i] *= wint;
            __builtin_amdgcn_sched_barrier(0);
            { const bf16x8 vf0 = ML_FRAG(ML_VT + vblk * 4096 + foff0), vf1 = ML_FRAG(ML_VT + vblk * 4096 + foff1);
              acc = mfma32(vf0, p0, acc); acc = mfma32(vf1, p1, acc); }
            if (tblk == 1) { const bf16x8 vf2 = ML_FRAG(ML_VT + vblk * 4096 + foff2), vf3 = ML_FRAG(ML_VT + vblk * 4096 + foff3); acc = mfma32(vf2, p2, acc); acc = mfma32(vf3, p3, acc); }
            const float inv = 1.f / fmaxf(fabsf(den), floorv);
            float sq = 0.f;
#pragma unroll
            for (int i = 0; i < 16; ++i) { acc[i] *= inv; sq += acc[i] * acc[i]; }
            sq = xhalf_sum(sq);
            LAS float* sqp = SSQ + (c & 1) * 256;
            if (hh == 0) sqp[vblk * 64 + t] = sq;
            asm volatile("s_waitcnt lgkmcnt(0)" ::: "memory"); __builtin_amdgcn_s_barrier(); asm volatile("" ::: "memory");
            const float tot = (sqp[t] + sqp[64 + t]) + (sqp[128 + t] + sqp[192 + t]);
            const float rinv = __builtin_amdgcn_rsqf(tot * (1.f / DV) + EPS);
            LAS unsigned char* otw = F.lds + ML_OT + w * (32 * 80) + r * 80 + 8 * hh;
#pragma unroll
            for (int gq = 0; gq < 4; ++gq) {
                const u32x4 ov4 = *(const LAS u32x4*)(buf + ML_OP + t * 256 + (((4 * vblk + gq) ^ (t & 15)) << 4));
                const f32x4 ghv = *(const LAS f32x4*)(GH + 32 * vblk + 8 * gq + 4 * hh);
                const unsigned ox = hh ? ov4.z : ov4.x, oy = hh ? ov4.w : ov4.y;
                const float o0 = bf_lo(ox), o1 = bf_hi(ox), o2 = bf_lo(oy), o3 = bf_hi(oy);
                const float y0 = acc[4 * gq + 0] * rinv * ghv[0] * fast_rcp(1.f + fast_exp(-o0));
                const float y1 = acc[4 * gq + 1] * rinv * ghv[1] * fast_rcp(1.f + fast_exp(-o1));
                const float y2 = acc[4 * gq + 2] * rinv * ghv[2] * fast_rcp(1.f + fast_exp(-o2));
                const float y3 = acc[4 * gq + 3] * rinv * ghv[3] * fast_rcp(1.f + fast_exp(-o3));
                u32x2 wv; wv.x = pk_bf16(y0, y1); wv.y = pk_bf16(y2, y3);
                *(LAS u32x2*)(otw + 16 * gq) = wv;
            }
            asm volatile("s_waitcnt lgkmcnt(0)" ::: "memory");
            {
                const LAS unsigned char* otr = F.lds + ML_OT + w * (32 * 80) + (lane >> 2) * 80 + (lane & 3) * 16;
                bf16* hp = hs + (tok0 + 32 * tblk + (lane >> 2)) * D + h * DV + 32 * vblk + 8 * (lane & 3);
                const u32x4 oa = *(const LAS u32x4*)otr, ob = *(const LAS u32x4*)(otr + 16 * 80);
                *(u32x4*)hp = oa; *(u32x4*)(hp + (size_t)16 * D) = ob;
            }
#pragma unroll
            for (int i = 0; i < 16; ++i) { Ct0[i] *= decay; Ct1[i] *= decay; Nt0[i] *= decay; Nt1[i] *= decay; }
            {
                const bf16x8 vfs[4] = {ML_FRAG(ML_VT + vblk * 4096 + foff0), ML_FRAG(ML_VT + vblk * 4096 + foff1), ML_FRAG(ML_VT + vblk * 4096 + foff2), ML_FRAG(ML_VT + vblk * 4096 + foff3)};
                const LAS unsigned char* ks = F.lds + ML_KS;
#pragma unroll
                for (int db = 0; db < 2; ++db) {
#pragma unroll
                    for (int f = 0; f < 4; ++f) {
                        const int sa = 16 * f + 4 * hh + tq, sb2 = sa + 8, ch = 4 * db + 2 * tg + (tp >> 1);
                        const v4i16_t lo = __builtin_amdgcn_ds_read_tr16_b64_v4i16((LAS v4i16_t*)(ks + sa * 128 + ((ch ^ ((sa >> 1) & 7)) << 4) + 8 * (tp & 1)));
                        const v4i16_t hi = __builtin_amdgcn_ds_read_tr16_b64_v4i16((LAS v4i16_t*)(ks + sb2 * 128 + ((ch ^ ((sb2 >> 1) & 7)) << 4) + 8 * (tp & 1)));
                        const bf16x8 kf = __builtin_shufflevector(lo, hi, 0, 1, 2, 3, 4, 5, 6, 7);
                        if (db == 0) { Ct0 = mfma32(kf, vfs[f], Ct0); Nt0 = mfma32(kf, ONES, Nt0); } else { Ct1 = mfma32(kf, vfs[f], Ct1); Nt1 = mfma32(kf, ONES, Nt1); }
                    }
                }
            }
            m_state = bL + M63;
        }
        asm volatile("s_waitcnt vmcnt(0) lgkmcnt(0)" ::: "memory"); __builtin_amdgcn_s_barrier(); asm volatile("" ::: "memory");
    }
#undef ML_DMA
#undef ML_ISSUE
#undef ML_FRAG
}

constexpr int AT_TBL = 0, AT_TBLN = 832;
constexpr int AT_RING = 8192, AT_SLOT = 16384, AT_QOFF = AT_RING + 3 * AT_SLOT;
constexpr int AT_STEPS = 84;
__device__ __forceinline__ void attn_decode(int rem, int& cg, int& kc) {
    if (rem < 4) { cg = 0; kc = rem; } else if (rem < 12) { cg = 1; kc = rem - 4; } else { const int q = (rem - 12) / 12; cg = 2 + q; kc = 4 * cg - 8 + (rem - 12) - 12 * q; }
}
__device__ __forceinline__ void attn_phase(const Frame& F, const bf16* qb, const bf16* kb, const bf16* vt, const float* rel, bf16* ao) {
    int lane_ = F.lane; asm volatile("" : "+v"(lane_));
    const int w = F.wave, lane = lane_, r = lane & 31, hh = lane >> 5, half = w & 1, co = w >> 1;
    LAS float* TB = (LAS float*)(F.lds + AT_TBL);
    LAS unsigned char* ringp = F.lds + AT_RING;
    const int P = w * 64 + lane, srow = P >> 3, scol = (P & 7) ^ ((srow >> 1) & 7);
    const int xs = (r >> 1) & 7;
    const int foff0 = r * 128 + (((0 + hh) ^ xs) << 4), foff1 = r * 128 + (((2 + hh) ^ xs) << 4), foff2 = r * 128 + (((4 + hh) ^ xs) << 4), foff3 = r * 128 + (((6 + hh) ^ xs) << 4);
    const int t = 32 * half + r;
    constexpr int NS = 2 * AT_STEPS;
#define AT_ISSUE(n_) do { const int nn_ = (n_) < NS ? (n_) : NS - 1; const int pi_ = nn_ / AT_STEPS; int cg_, kc_; attn_decode(nn_ - pi_ * AT_STEPS, cg_, kc_); \
        const int bh_ = 2 * pr + pi_, b_ = bh_ / BH, hd_ = bh_ % BH; const size_t kt_ = (size_t)b_ * SEQ + (size_t)kc_ * CH; \
        const bf16* gk_ = kb + (kt_ + srow) * D + hd_ * DHD + scol * 8; const bf16* gv_ = vt + (size_t)(hd_ * DHD + srow) * M + kt_ + scol * 8; \
        LAS unsigned char* dst_ = ringp + ((n_) % 3) * AT_SLOT + w * 1024; \
        __builtin_amdgcn_global_load_lds((const unsigned*)gk_, (LAS unsigned*)dst_, 16, 0, 0); \
        __builtin_amdgcn_global_load_lds((const unsigned*)gv_, (LAS unsigned*)(dst_ + 8192), 16, 0, 0); } while (0)
#define AT_QDMA(pi_, cg_) do { const int bh_ = 2 * pr + (pi_), b_ = bh_ / BH, hd_ = bh_ % BH; \
        const bf16* qp_ = qb + ((size_t)b_ * SEQ + (size_t)(4 * (cg_) + co) * CH + 32 * half) * D + hd_ * DHD; \
        _Pragma("unroll") for (int i_ = 0; i_ < 4; ++i_) { const int row_ = 8 * i_ + (lane >> 3), col_ = (lane & 7) ^ ((row_ >> 1) & 7); \
            __builtin_amdgcn_global_load_lds((const unsigned*)(qp_ + (size_t)row_ * D + col_ * 8), (LAS unsigned*)(qlds + i_ * 1024), 16, 0, 0); } } while (0)
    LAS unsigned char* qlds = F.lds + AT_QOFF + w * 4096;
    LAS unsigned char* otl = F.lds + AT_QOFF + 8 * 4096 + w * (32 * 144);
    for (int pr = F.bx; pr < NBATCH * BH / 2; pr += F.G) {
        asm volatile("s_waitcnt vmcnt(0) lgkmcnt(0)" ::: "memory"); __builtin_amdgcn_s_barrier(); asm volatile("" ::: "memory");
        for (int e = F.tid; e < 2 * AT_TBLN; e += NWAVES * 64) { const int pi = e / AT_TBLN, ix = e % AT_TBLN; const int hd = (2 * pr + pi) % BH; TB[e] = rel[hd * NREL + (ix < 512 ? ix : 512)] * LOG2E; }
        asm volatile("s_waitcnt vmcnt(0) lgkmcnt(0)" ::: "memory"); __builtin_amdgcn_s_barrier(); asm volatile("" ::: "memory");
        AT_QDMA(0, 0);
        asm volatile("s_waitcnt vmcnt(0)" ::: "memory");
        AT_ISSUE(0); AT_ISSUE(1);
        bf16x8 qf[4];
        f32x16 O0 = zero16(), O1 = zero16();
        float m_run = 0.f, lsum = 0.f;
        if (w >= 4) { asm volatile("s_waitcnt vmcnt(2)" ::: "memory"); __builtin_amdgcn_s_barrier(); asm volatile("" ::: "memory"); }
        for (int n = 0; n < NS; ++n) {
            const int pi = n / AT_STEPS; int cg, kc; attn_decode(n - pi * AT_STEPS, cg, kc);
            const int c = 4 * cg + co;
            if (w < 4) asm volatile("s_waitcnt vmcnt(2)" ::: "memory");
            asm volatile("" ::: "memory"); __builtin_amdgcn_s_barrier(); asm volatile("" ::: "memory");
            AT_ISSUE(n + 2);
            const int kfirst = c < 8 ? 0 : c - 8;
            if (kc == kfirst) {
                qf[0] = *(const LAS bf16x8*)(qlds + foff0); qf[1] = *(const LAS bf16x8*)(qlds + foff1); qf[2] = *(const LAS bf16x8*)(qlds + foff2); qf[3] = *(const LAS bf16x8*)(qlds + foff3);
                O0 = zero16(); O1 = zero16(); m_run = 0.f; lsum = 0.f;
                int npi = pi, ncg = cg + 1; if (ncg == 8) { ncg = 0; npi = pi + 1; }
                asm volatile("s_waitcnt lgkmcnt(0)" ::: "memory");
                if (npi < 2) AT_QDMA(npi, ncg);
            }
            const bool act = (kc >= kfirst && kc <= c);
            f32x16 S0, S1; bf16x8 vf0, vf1, vf2, vf3, vf4, vf5, vf6, vf7;
            if (act) {
                const int j = kc - (c - 8);
                const LAS float* tb = TB + pi * AT_TBLN;
                const LAS unsigned char* sl = ringp + (n % 3) * AT_SLOT;
                const LAS unsigned char* a0 = sl + foff0; const LAS unsigned char* a1 = sl + foff1; const LAS unsigned char* a2 = sl + foff2; const LAS unsigned char* a3 = sl + foff3;
                bf16x8 kf0 = *(const LAS bf16x8*)(a0), kf1 = *(const LAS bf16x8*)(a1), kf2 = *(const LAS bf16x8*)(a2), kf3 = *(const LAS bf16x8*)(a3);
                bf16x8 kf4 = *(const LAS bf16x8*)(a0 + 4096), kf5 = *(const LAS bf16x8*)(a1 + 4096), kf6 = *(const LAS bf16x8*)(a2 + 4096), kf7 = *(const LAS bf16x8*)(a3 + 4096);
                {
                    const LAS float* pb = tb + ((8 - j) * 64 + t + 256 - 63 - 4 * hh);
#pragma unroll
                    for (int i = 0; i < 16; ++i) { const int ci = (i & 3) + 8 * (i >> 2); S0[i] = pb[63 - ci]; S1[i] = pb[63 - ci - 32]; }
                }
                asm volatile("" : "+v"(kf0), "+v"(kf1), "+v"(kf2), "+v"(kf3), "+v"(kf4), "+v"(kf5), "+v"(kf6), "+v"(kf7), "+v"(S0), "+v"(S1));
                S0 = mfma32(kf0, qf[0], S0); S1 = mfma32(kf4, qf[0], S1); S0 = mfma32(kf1, qf[1], S0); S1 = mfma32(kf5, qf[1], S1);
                S0 = mfma32(kf2, qf[2], S0); S1 = mfma32(kf6, qf[2], S1); S0 = mfma32(kf3, qf[3], S0); S1 = mfma32(kf7, qf[3], S1);
                vf0 = *(const LAS bf16x8*)(a0 + 8192); vf1 = *(const LAS bf16x8*)(a1 + 8192); vf2 = *(const LAS bf16x8*)(a2 + 8192); vf3 = *(const LAS bf16x8*)(a3 + 8192);
                vf4 = *(const LAS bf16x8*)(a0 + 12288); vf5 = *(const LAS bf16x8*)(a1 + 12288); vf6 = *(const LAS bf16x8*)(a2 + 12288); vf7 = *(const LAS bf16x8*)(a3 + 12288);
            }
            if (w >= 4) asm volatile("s_waitcnt vmcnt(2)" ::: "memory");
            asm volatile("s_waitcnt lgkmcnt(0)" ::: "memory"); __builtin_amdgcn_s_barrier(); asm volatile("" ::: "memory");
            if (act) {
                float mx = -3.0e38f;
#pragma unroll
                for (int i = 0; i < 16; ++i) { S0[i] -= m_run; S1[i] -= m_run; mx = fmaxf(mx, fmaxf(S0[i], S1[i])); }
                mx = xhalf_max(mx);
                const bool first = (kc == kfirst);
                if (first || __any(mx > 8.0f)) {
                    const float dm = first ? mx : (mx > 8.0f ? mx : 0.f);
                    const float alpha = first ? 0.f : fast_exp2(-dm);
                    m_run += dm; lsum *= alpha;
#pragma unroll
                    for (int i = 0; i < 16; ++i) { O0[i] *= alpha; O1[i] *= alpha; S0[i] -= dm; S1[i] -= dm; }
                }
                float ps = 0.f;
#pragma unroll
                for (int i = 0; i < 16; ++i) { S0[i] = fast_exp2(S0[i]); S1[i] = fast_exp2(S1[i]); ps += S0[i] + S1[i]; }
                lsum += ps;
                const bf16x8 p0 = pack8(S0, 0), p1 = pack8(S0, 1), p2 = pack8(S1, 0), p3 = pack8(S1, 1);
                asm volatile("" : "+v"(vf0), "+v"(vf1), "+v"(vf2), "+v"(vf3), "+v"(vf4), "+v"(vf5), "+v"(vf6), "+v"(vf7));
                O0 = mfma32(vf0, p0, O0); O1 = mfma32(vf4, p0, O1); O0 = mfma32(vf1, p1, O0); O1 = mfma32(vf5, p1, O1);
                O0 = mfma32(vf2, p2, O0); O1 = mfma32(vf6, p2, O1); O0 = mfma32(vf3, p3, O0); O1 = mfma32(vf7, p3, O1);
                if (kc == c) {
                    const float ltot = xhalf_sum(lsum);
                    const float inv = 1.f / ltot;
                    const int bh = 2 * pr + pi, b = bh / BH, hd = bh % BH;
                    LAS unsigned char* tw = otl + r * 144 + 8 * hh;
#pragma unroll
                    for (int gq = 0; gq < 4; ++gq) {
                        u32x2 w0; w0.x = pk_bf16(O0[4 * gq] * inv, O0[4 * gq + 1] * inv); w0.y = pk_bf16(O0[4 * gq + 2] * inv, O0[4 * gq + 3] * inv);
                        u32x2 w1; w1.x = pk_bf16(O1[4 * gq] * inv, O1[4 * gq + 1] * inv); w1.y = pk_bf16(O1[4 * gq + 2] * inv, O1[4 * gq + 3] * inv);
                        *(LAS u32x2*)(tw + 16 * gq) = w0; *(LAS u32x2*)(tw + 64 + 16 * gq) = w1;
                    }
                    asm volatile("s_waitcnt lgkmcnt(0)" ::: "memory");
                    bf16* op = ao + ((size_t)b * SEQ + (size_t)c * CH + 32 * half + (lane >> 3)) * D + hd * DHD + 8 * (lane & 7);
                    const LAS unsigned char* tr = otl + (lane >> 3) * 144 + (lane & 7) * 16;
#pragma unroll
                    for (int k8 = 0; k8 < 4; ++k8) { const u32x4 ov = *(const LAS u32x4*)(tr + k8 * 8 * 144); *(u32x4*)(op + (size_t)(8 * k8) * D) = ov; }
                    asm volatile("s_waitcnt lgkmcnt(0)" ::: "memory");
                }
            }
        }
        if (w < 4) { asm volatile("" ::: "memory"); __builtin_amdgcn_s_barrier(); asm volatile("" ::: "memory"); }
        asm volatile("s_waitcnt vmcnt(0) lgkmcnt(0)" ::: "memory"); __builtin_amdgcn_s_barrier(); asm volatile("" ::: "memory");
    }
#undef AT_ISSUE
#undef AT_QDMA
}

constexpr int N_PHASES = 22;
#ifndef DUPMASK
#define DUPMASK 0
#endif
#define REP(bit) for (int rep_ = 0; rep_ < (((DUPMASK) & (bit)) ? 2 : 1); ++rep_)
#define REPBAR() do { if (rep_) xcd_barrier(bar); } while (0)
__global__ void __launch_bounds__(NWAVES * 64, 2) yoco_fwd(Args args) {
    extern __shared__ __attribute__((aligned(16))) unsigned char lds[];
    Frame F;
    F.lds = (LAS unsigned char*)lds;
    F.tid = threadIdx.x; F.lane = F.tid & 63; F.wave = __builtin_amdgcn_readfirstlane(F.tid >> 6);
    F.G = gridDim.x; F.bx = blockIdx.x;
    unsigned char* ws = args.ws;
    unsigned* ctl = (unsigned*)(ws + WS_CTL);
    for (int u = F.tid; u < (LDS_BYTES - LDSCTL_OFF) / 4; u += NWAVES * 64) ((LAS unsigned*)(F.lds + LDSCTL_OFF))[u] = 0u;
    __syncthreads();
    volatile LAS unsigned* MISC = (volatile LAS unsigned*)(F.lds + MISC_OFF);
    XcdBarrier bar = xcd_barrier_post(ctl + CW_BAR, MISC + 8);
    const int lo = args.ph_lo, hi = args.ph_hi;
#define IN(k) (lo <= (k) && (k) < hi)
#define SEAM(k) do { if (IN(k) && IN((k) + 1)) xcd_barrier(bar); } while (0)
    float* out = args.out;
    bf16* XN = (bf16*)(ws + WS_XN); bf16* H = (bf16*)(ws + WS_H);
    bf16* KB = (bf16*)out; bf16* VT = (bf16*)out + (size_t)M * D;
    bf16* BIG = (bf16*)(ws + WS_BIG); bf16* KVT = (bf16*)(ws + WS_KVT); float* GATES = (float*)(ws + WS_GATES);
    u64* SSQ = (u64*)(ws + WS_SSQ);
    LAS unsigned char* ring = F.lds;

    if (IN(0)) REP(1) { REPBAR(); p0_prologue(F, args); xconv_phase(F, args.in[I_X], H, SSQ); } SEAM(0);

    for (int l = 0; l < 4; ++l) {
        const int p = 1 + 5 * l;
        const u64* ssq_in = SSQ + (size_t)(2 * l) * M; u64* ssq_mid = SSQ + (size_t)(2 * l + 1) * M; u64* ssq_out = SSQ + (size_t)(2 * l + 2) * M;
        if (IN(p)) REP(4) { REPBAR();
            const bf16* wn; int nn; bf16* on; int ldn, splitc; bf16* on2;
            const bf16* wsw; int msw; bf16* osw;
            if (l < 2) {
                unsigned char* wb = ws + WS_WA + (size_t)l * WA_STRIDE;
                gates_phase(F, H, ssq_in, (const bf16*)(wb + WA_G), args.in[I_ABG] + l * 16, GATES);
                wn = (const bf16*)(wb + WA_QKO); nn = 2048; on = BIG; ldn = 2048; splitc = 0; on2 = nullptr;
                wsw = (const bf16*)(wb + WA_KV); msw = 1024; osw = KVT;
            } else if (l == 2) {
                wn = (const bf16*)(ws + WS_WQK2); nn = 2048; on = BIG; ldn = 1024; splitc = 1024; on2 = KB;
                wsw = (const bf16*)(ws + WS_WV); msw = 1024; osw = VT;
            } else {
                wn = (const bf16*)(ws + WS_WQ3); nn = 1024; on = BIG; ldn = 1024; splitc = 0; on2 = nullptr;
                wsw = nullptr; msw = 0; osw = nullptr;
            }
            { pg8::Gemm g{H, wn, M, nn, D}; pg8::StaticOrder S; S.init(M, nn, F.G, F.bx);
              pg8::EpiBf16 E{on, ldn, splitc, on2, ssq_in};
              pg8::gemm_phase<pg8::EpiBf16, pg8::StaticOrder, true, true>(ring, g, S, E); }
            if (msw) { pg8::Gemm g{wsw, H, msw, M, D}; pg8::StaticOrder S; S.init(msw, M, F.G, F.bx);
              pg8::EpiBf16K E{osw, M, 0, nullptr, ssq_in};
              pg8::gemm_phase<pg8::EpiBf16K, pg8::StaticOrder, true, true>(ring, g, S, E); }
        }
        SEAM(p);
        if (IN(p + 1)) REP(l < 2 ? 8 : 16) { REPBAR();
            if (l < 2) mlstm_phase(F, BIG, KVT, GATES, args.in[I_AGH] + l * D, XN);
            else attn_phase(F, BIG, KB, VT, args.in[I_BREL] + (size_t)(l - 2) * BH * NREL, XN);
        }
        SEAM(p + 1);
        if (IN(p + 2)) {
            const bf16* wo = (l < 2) ? (const bf16*)(ws + WS_WA + (size_t)l * WA_STRIDE + WA_OUT) : (const bf16*)(ws + WS_WO + (size_t)(l - 2) * 2 * MiB);
            pg8::Gemm g{XN, wo, M, D, D}; pg8::StaticOrder S; S.init(M, D, F.G, F.bx);
            pg8::EpiRes E{H, ssq_mid};
            pg8::gemm_phase<pg8::EpiRes, pg8::StaticOrder, true, true>(ring, g, S, E);
        }
        SEAM(p + 2);
        if (IN(p + 3)) REP(64) { REPBAR();
            pg8::Gemm g{H, (const bf16*)(ws + WS_WF + (size_t)l * WF_STRIDE), M, 2 * FF, D}; pg8::StaticOrder S; S.init(M, 2 * FF, F.G, F.bx);
            pg8::EpiSwiglu E{BIG, FF, ssq_mid};
            pg8::gemm_phase<pg8::EpiSwiglu, pg8::StaticOrder, true, true>(ring, g, S, E);
        }
        SEAM(p + 3);
        if (IN(p + 4)) {
            pg8::Gemm g{BIG, (const bf16*)(ws + WS_WF + (size_t)l * WF_STRIDE + WF_D), M, D, FF}; pg8::StaticOrder S; S.init(M, D, F.G, F.bx);
            pg8::EpiRes E{H, ssq_out};
            pg8::gemm_phase<pg8::EpiRes, pg8::StaticOrder, true, true>(ring, g, S, E);
        }
        SEAM(p + 4);
    }
    if (IN(21)) REP(128) { REPBAR(); final_norm_phase(F, H, SSQ + (size_t)8 * M, args.in[I_FING], out); }
#undef IN
#undef SEAM
}

extern "C" void kernel_launch(void* const* d_in, const int* in_sizes, int n_in, void* d_out, int out_size, void* d_ws, size_t ws_size, hipStream_t stream) {
    static int grid = 0;
    if (grid == 0) {
        if (n_in != 16 || out_size != M * D || ws_size < WS_END) { fprintf(stderr, "kernel_launch: unexpected shapes (n_in %d, out %d, ws %zu < %zu)\n", n_in, out_size, ws_size, (size_t)WS_END); }
        int dev = 0, cus = 0, per_cu = 0;
        hipGetDevice(&dev); hipDeviceGetAttribute(&cus, hipDeviceAttributeMultiprocessorCount, dev);
        hipFuncSetAttribute((const void*)yoco_fwd, hipFuncAttributeMaxDynamicSharedMemorySize, LDS_BYTES);
        hipOccupancyMaxActiveBlocksPerMultiprocessor(&per_cu, (const void*)yoco_fwd, NWAVES * 64, LDS_BYTES);
        (void)hipGetLastError();
        grid = cus > 0 ? cus : 256;
        if (per_cu < 1) fprintf(stderr, "kernel_launch: occupancy query says %d\n", per_cu);
    }
    hipMemsetAsync((char*)d_ws + WS_CTL, 0, CTL_ZERO_BYTES, stream);
    Args a{};
    for (int i = 0; i < 16; ++i) a.in[i] = (const float*)d_in[i];
    a.out = (float*)d_out; a.ws = (unsigned char*)d_ws;
#if MK_N_LAUNCHES == 1
    a.ph_lo = 0; a.ph_hi = N_PHASES;
    hipLaunchKernelGGL(yoco_fwd, dim3(grid), dim3(NWAVES * 64), LDS_BYTES, stream, a);
#else
    for (int p = 0; p < N_PHASES; ++p) { a.ph_lo = p; a.ph_hi = p + 1; hipLaunchKernelGGL(yoco_fwd, dim3(grid), dim3(NWAVES * 64), LDS_BYTES, stream, a); }
#endif
}
```

```cpp
#include <hip/hip_runtime.h>
#include <cstdio>
#include <cstdint>

#ifndef MK_N_LAUNCHES
#define MK_N_LAUNCHES 1
#endif

#define GAS __attribute__((address_space(1)))
#define LAS __attribute__((address_space(3)))
typedef unsigned short bf16;
typedef short bf16x8 __attribute__((ext_vector_type(8)));
typedef float f32x2 __attribute__((ext_vector_type(2)));
typedef float f32x4 __attribute__((ext_vector_type(4)));
typedef float f32x16 __attribute__((ext_vector_type(16)));
typedef unsigned u32x2 __attribute__((ext_vector_type(2)));
typedef unsigned u32x4 __attribute__((ext_vector_type(4)));
typedef __bf16 bf16x2_t __attribute__((ext_vector_type(2)));

constexpr int M = 65536, D = 1024, SEQ = 2048, NBATCH = 32, CH = 64, NCH = 32;
constexpr int AH = 8, DQK = 64, DV = 128, AIN = 3088;
constexpr int BH = 16, DHD = 64, FF = 2816, NREL = 513;
constexpr float EPS = 1e-6f;
constexpr float LOG2E = 1.4426950408889634f;
typedef unsigned long long u64;
constexpr float SSQ_FIX = 1048576.0f;
__device__ __forceinline__ float rstd_of(u64 q) { return __builtin_amdgcn_rsqf((float)q * (1.0f / (1048576.0f * 1024.0f)) + 1e-6f); }

__device__ __forceinline__ unsigned pk_bf16(float lo, float hi) { f32x2 v = {lo, hi}; bf16x2_t b = __builtin_convertvector(v, bf16x2_t); return __builtin_bit_cast(unsigned, b); }
__device__ __forceinline__ float bf_lo(unsigned u) { return __uint_as_float(u << 16); }
__device__ __forceinline__ float bf_hi(unsigned u) { return __uint_as_float(u & 0xffff0000u); }
__device__ __forceinline__ float fast_exp2(float x) { return __builtin_amdgcn_exp2f(x); }
__device__ __forceinline__ float fast_exp(float x) { return __builtin_amdgcn_exp2f(x * LOG2E); }
__device__ __forceinline__ float fast_rcp(float x) { return __builtin_amdgcn_rcpf(x); }

namespace pg8 {
#define PG8_LAS __attribute__((address_space(3)))
typedef unsigned short bf16_t;
constexpr int BM = 256, BK = 64, HALF = 128, HTB = HALF * BK * 2, STAGE_BYTES = 8 * HTB, NXCD = 8, WGM = 8;
constexpr int EPI_T_OFF = STAGE_BYTES + 6144, EPI_T_WAVE = 16 * 144;
constexpr int SIDE_OFF = STAGE_BYTES + 1024, SIDE_BYTES = 2048;

__host__ __device__ __forceinline__ int lds_byte(int r, int c) { const int st = (r >> 4) * 2 + (c >> 5), rr = r & 15, cc = c & 31, ob = rr * 64 + cc * 2; return st * 1024 + (ob ^ (((ob >> 9) & 1) << 5)); }
__host__ __device__ __forceinline__ void stage_rc(int b, int& R, int& C) { const int st = b / 1024, sb = b % 1024, swz = sb ^ (((sb >> 9) & 1) << 5); R = (st >> 1) * 16 + swz / 64; C = (st & 1) * 32 + (swz % 64) / 2; }
__host__ __device__ __forceinline__ int perm32(int rho) { const int n = rho >> 4, i = rho & 15; return 8 * (i >> 2) + 4 * n + (i & 3); }
__host__ __device__ __forceinline__ int perm32k(int rho) { const int n = rho >> 4, i = rho & 15, fq = i >> 2, e = i & 3; return 16 * (fq >> 1) + 4 * (fq & 1) + 8 * n + e; }

struct Unit { int pm, pn; };
struct Gemm { const bf16_t* A; const bf16_t* Bt; int M, N, K; };

struct StaticOrder {
    int nM, nN, nwg, G, c;
    __host__ __device__ void init(int M_, int N_, int G_, int c_) { nM = M_ / BM; nN = N_ / BM; nwg = nM * nN; G = G_; c = c_; }
    __host__ __device__ bool next(int i, Unit& u) const {
        const long L = (long)i * G + c; if (L >= nwg) return false;
        int wgid = (int)L; { const int q = nwg / NXCD, r = nwg % NXCD, xcd = wgid % NXCD, off = wgid / NXCD; wgid = (xcd < r ? xcd * (q + 1) : r * (q + 1) + (xcd - r) * q) + off; }
        const int nig = WGM * nN, gid = wgid / nig, fm = gid * WGM, gsz = (nM - fm) < WGM ? (nM - fm) : WGM;
        u.pm = fm + ((wgid % nig) % gsz); u.pn = (wgid % nig) / gsz; return true;
    }
    __device__ __forceinline__ void a_ready(const Unit&) const {}
    __device__ __forceinline__ void done(const Unit&) const {}
};

template <bool KPERM> struct EpiBf16T {
    static constexpr bool PERM = true, AFTER_DRAIN = false, WIDE = true;
    static __host__ __device__ __forceinline__ int permf(int rho) { return KPERM ? perm32k(rho) : perm32(rho); }
    bf16_t* O; int ldc; int split_cols; bf16_t* O2; const u64* ssq;
    __device__ __forceinline__ void prestage(PG8_LAS unsigned char* lds, const Unit& u, int par, int wid, int lane) const {
        if (wid < 2) { const int t0 = (KPERM ? u.pn : u.pm) * BM + 128 * wid;
            __builtin_amdgcn_global_load_lds((const unsigned*)(ssq + t0 + 2 * lane), (PG8_LAS unsigned*)(lds + SIDE_OFF + par * SIDE_BYTES + wid * 1024), 16, 0, 0); }
    }
    __device__ __forceinline__ void operator()(const f32x4 (&acc)[2][2][4][2], const Unit& u, int wr, int wc, int fr, int fq, const PG8_LAS unsigned char* side, PG8_LAS unsigned char* tl, int lane) const {
        int colt = u.pn * BM; bf16_t* base = O;
        if (split_cols && colt >= split_cols) { base = O2; colt -= split_cols; }
        const PG8_LAS u64* sq = (const PG8_LAS u64*)side;
        float rs[2][4]; f32x4 cs[2][2];
        if constexpr (!KPERM) {
#pragma unroll
            for (int ai = 0; ai < 2; ++ai)
#pragma unroll
                for (int m = 0; m < 4; ++m) rs[ai][m] = rstd_of(sq[wr * 64 + fr + ai * HALF + m * 16]);
        } else {
            const int tok0 = wc * 64 + 16 * (fq >> 1) + 4 * (fq & 1);
#pragma unroll
            for (int bj = 0; bj < 2; ++bj)
#pragma unroll
                for (int n = 0; n < 2; ++n) {
#pragma unroll
                    for (int e = 0; e < 4; ++e) cs[bj][n][e] = rstd_of(sq[tok0 + bj * 32 + 8 * n + e]); }
        }
        PG8_LAS unsigned char* wp = tl + fr * 144 + fq * 16;
        const PG8_LAS unsigned char* rp = tl + (lane >> 3) * 144 + (lane & 7) * 16;
        bf16_t* gp = base + (size_t)(u.pm * BM + wr * 64 + (lane >> 3)) * ldc + colt + wc * 64 + 8 * (lane & 7);
#pragma unroll
        for (int ai = 0; ai < 2; ++ai)
#pragma unroll
            for (int m = 0; m < 4; ++m) {
#pragma unroll
                for (int bj = 0; bj < 2; ++bj) { f32x4 v0 = acc[ai][bj][m][0], v1 = acc[ai][bj][m][1];
                    if constexpr (!KPERM) { v0 = v0 * rs[ai][m]; v1 = v1 * rs[ai][m]; } else { v0 = v0 * cs[bj][0]; v1 = v1 * cs[bj][1]; }
                    u32x4 w; w.x = pk_bf16(v0[0], v0[1]); w.y = pk_bf16(v0[2], v0[3]); w.z = pk_bf16(v1[0], v1[1]); w.w = pk_bf16(v1[2], v1[3]);
                    *(PG8_LAS u32x4*)(wp + bj * 64) = w; }
                asm volatile("s_waitcnt lgkmcnt(0)" ::: "memory");
                const u32x4 o0 = *(const PG8_LAS u32x4*)rp, o1 = *(const PG8_LAS u32x4*)(rp + 8 * 144);
                asm volatile("s_waitcnt lgkmcnt(0)" ::: "memory");
                bf16_t* g0 = gp + (size_t)(ai * HALF + m * 16) * ldc;
                __builtin_nontemporal_store(o0, (u32x4*)g0); __builtin_nontemporal_store(o1, (u32x4*)(g0 + (size_t)8 * ldc));
            }
    }
};
typedef EpiBf16T<false> EpiBf16;
typedef EpiBf16T<true> EpiBf16K;
struct EpiSwiglu {
    static constexpr bool PERM = true, AFTER_DRAIN = false, WIDE = false;
    static __host__ __device__ __forceinline__ int permf(int rho) { return perm32(rho); }
    bf16_t* O; int ldc; const u64* ssq;
    __device__ __forceinline__ void prestage(PG8_LAS unsigned char* lds, const Unit& u, int par, int wid, int lane) const {
        if (wid < 2) { const int t0 = u.pm * BM + 128 * wid;
            __builtin_amdgcn_global_load_lds((const unsigned*)(ssq + t0 + 2 * lane), (PG8_LAS unsigned*)(lds + SIDE_OFF + par * SIDE_BYTES + wid * 1024), 16, 0, 0); }
    }
    __device__ __forceinline__ void operator()(const f32x4 (&acc)[2][2][4][2], const Unit& u, int wr, int wc, int fr, int fq, const PG8_LAS unsigned char* side, PG8_LAS unsigned char*, int) const {
        const int row0 = u.pm * BM + wr * 64 + fr; const int col0 = u.pn * HALF + wc * 32 + 8 * fq;
        const PG8_LAS u64* sq = (const PG8_LAS u64*)side;
#pragma unroll
        for (int ai = 0; ai < 2; ++ai)
#pragma unroll
            for (int m = 0; m < 4; ++m) { const int row = row0 + ai * HALF + m * 16; bf16_t* rowp = O + (size_t)row * ldc + col0;
                const float rs = rstd_of(sq[wr * 64 + fr + ai * HALF + m * 16]);
                float o[8];
#pragma unroll
                for (int n = 0; n < 2; ++n)
#pragma unroll
                    for (int e = 0; e < 4; ++e) { const float g = acc[ai][0][m][n][e] * rs, up = acc[ai][1][m][n][e] * rs;
                        o[4 * n + e] = g * fast_rcp(1.0f + fast_exp2(-g * LOG2E)) * up; }
                u32x4 w; w.x = pk_bf16(o[0], o[1]); w.y = pk_bf16(o[2], o[3]); w.z = pk_bf16(o[4], o[5]); w.w = pk_bf16(o[6], o[7]);
                __builtin_nontemporal_store(w, (u32x4*)rowp); }
    }
};
struct EpiRes {
    static constexpr bool PERM = true, AFTER_DRAIN = false, WIDE = true;
    static __host__ __device__ __forceinline__ int permf(int rho) { return perm32(rho); }
    bf16_t* H; u64* ssq_out;
    __device__ __forceinline__ void prestage(PG8_LAS unsigned char*, const Unit&, int, int, int) const {}
    __device__ __forceinline__ void operator()(const f32x4 (&acc)[2][2][4][2], const Unit& u, int wr, int wc, int fr, int fq, const PG8_LAS unsigned char*, PG8_LAS unsigned char* tl, int lane) const {
        const int row0 = u.pm * BM + wr * 64 + fr, col0 = u.pn * BM + wc * 64 + 8 * fq;
        PG8_LAS unsigned char* ap = tl + fr * 144 + fq * 16;
        const PG8_LAS unsigned char* rp = tl + (lane >> 3) * 144 + (lane & 7) * 16;
        bf16_t* gp = H + (size_t)(u.pm * BM + wr * 64 + (lane >> 3)) * D + u.pn * BM + wc * 64 + 8 * (lane & 7);
#pragma unroll
        for (int ai = 0; ai < 2; ++ai) {
            u32x4 hv8[4][2];
#pragma unroll
            for (int m = 0; m < 4; ++m)
#pragma unroll
                for (int bj = 0; bj < 2; ++bj) hv8[m][bj] = *(const u32x4*)(H + (size_t)(row0 + ai * HALF + m * 16) * D + col0 + bj * 32);
#pragma unroll
            for (int m = 0; m < 4; ++m) { const int row = row0 + ai * HALF + m * 16; float part = 0.f;
#pragma unroll
                for (int bj = 0; bj < 2; ++bj) { const u32x4 hv = hv8[m][bj];
                    const f32x4 a0 = acc[ai][bj][m][0], a1 = acc[ai][bj][m][1];
                    const float y0 = a0[0] + bf_lo(hv.x), y1 = a0[1] + bf_hi(hv.x), y2 = a0[2] + bf_lo(hv.y), y3 = a0[3] + bf_hi(hv.y);
                    const float y4 = a1[0] + bf_lo(hv.z), y5 = a1[1] + bf_hi(hv.z), y6 = a1[2] + bf_lo(hv.w), y7 = a1[3] + bf_hi(hv.w);
                    part += ((y0 * y0 + y1 * y1) + (y2 * y2 + y3 * y3)) + ((y4 * y4 + y5 * y5) + (y6 * y6 + y7 * y7));
                    u32x4 w; w.x = pk_bf16(y0, y1); w.y = pk_bf16(y2, y3); w.z = pk_bf16(y4, y5); w.w = pk_bf16(y6, y7);
                    *(PG8_LAS u32x4*)(ap + bj * 64) = w; }
                asm volatile("s_waitcnt lgkmcnt(0)" ::: "memory");
                const u32x4 o0 = *(const PG8_LAS u32x4*)rp, o1 = *(const PG8_LAS u32x4*)(rp + 8 * 144);
                asm volatile("s_waitcnt lgkmcnt(0)" ::: "memory");
                bf16_t* g0 = gp + (size_t)(ai * HALF + m * 16) * D;
                *(u32x4*)g0 = o0; *(u32x4*)(g0 + (size_t)8 * D) = o1;
                part += __shfl_xor(part, 16); part += __shfl_xor(part, 32);
                if (fq == 0) atomicAdd(ssq_out + row, (u64)(part * SSQ_FIX)); }
        }
    }
};

template <class Epi, class Sched, bool ALIGN_EPI = false, bool SP2 = false>
__device__ __forceinline__ void gemm_phase(PG8_LAS unsigned char* lds, const Gemm g, const Sched& S, const Epi& E) {
    int tid_ = threadIdx.x; asm volatile("" : "+v"(tid_));
    const int tid = tid_, wid = __builtin_amdgcn_readfirstlane(tid >> 6), lane = tid & 63, wr = wid >> 2, wc = wid & 3, fr = lane & 15, fq = lane >> 4;
    const int K = g.K, nt = K / BK;
    unsigned voffA[2], voffB[2];
#pragma unroll
    for (int i = 0; i < 2; ++i) { int R, C; stage_rc(tid * 16 + i * 8192, R, C); const int Rb = Epi::WIDE ? (64 * (R >> 5) + Epi::permf(R & 31)) : (Epi::PERM ? ((R & ~31) + Epi::permf(R & 31)) : R);
        voffA[i] = (unsigned)(R * K + C) * 2u; voffB[i] = (unsigned)(Rb * K + C) * 2u; }
    const size_t kstep = (size_t)(BK * 2);
    const size_t hstep = (size_t)HALF * K * 2;
    const size_t hstepB = Epi::WIDE ? (size_t)32 * K * 2 : hstep;
    const size_t tstep = 2 * hstep;
    const unsigned ldsw = (unsigned)wid * 1024u;
    const int aoff = lds_byte(wr * 64 + fr, fq * 8), boff = lds_byte(wc * 32 + fr, fq * 8);
#define PG8_SA(b, h) (((b) * 2 + (h)) * HTB)
#define PG8_SB(b, h) ((4 + (b) * 2 + (h)) * HTB)
#define PG8_STAGE(bufoff, gbase, voff) do { _Pragma("unroll") for (int _i = 0; _i < 2; ++_i) \
        __builtin_amdgcn_global_load_lds((const unsigned*)((const char*)(gbase) + (voff)[_i]), (PG8_LAS unsigned*)(lds + (bufoff) + ldsw + _i * 8192), 16, 0, 0); } while (0)
#define PG8_LDA(dst, b, h) do { _Pragma("unroll") for (int m = 0; m < 4; ++m) _Pragma("unroll") for (int k = 0; k < 2; ++k) dst[m][k] = *(const PG8_LAS bf16x8*)(lds + PG8_SA(b, h) + aoff + m * 2048 + k * 1024); } while (0)
#define PG8_LDB(dst, b, h) do { _Pragma("unroll") for (int n = 0; n < 2; ++n) _Pragma("unroll") for (int k = 0; k < 2; ++k) dst[n][k] = *(const PG8_LAS bf16x8*)(lds + PG8_SB(b, h) + boff + n * 2048 + k * 1024); } while (0)
#define PG8_MMA(ai, bj, At, Bt) do { __builtin_amdgcn_s_setprio(1); _Pragma("unroll") for (int m = 0; m < 4; ++m) _Pragma("unroll") for (int n = 0; n < 2; ++n) _Pragma("unroll") for (int k = 0; k < 2; ++k) \
        acc[ai][bj][m][n] = __builtin_amdgcn_mfma_f32_16x16x32_bf16(Bt[n][k], At[m][k], acc[ai][bj][m][n], 0, 0, 0); __builtin_amdgcn_s_setprio(0); } while (0)
#define PG8_WAIT_V(n) asm volatile("s_waitcnt vmcnt(" #n ")" ::: "memory")
#define PG8_WAIT_L(n) asm volatile("s_waitcnt lgkmcnt(" #n ")" ::: "memory")
#define PG8_BAR __builtin_amdgcn_s_barrier()
#define PG8_SCHED __builtin_amdgcn_sched_barrier(0)
    Unit cur, nxt; int ui = 0;
    if (!S.next(0, cur)) return;
    f32x4 acc[2][2][4][2];
#pragma unroll
    for (int a = 0; a < 2; ++a)
#pragma unroll
        for (int b = 0; b < 2; ++b)
#pragma unroll
            for (int m = 0; m < 4; ++m)
#pragma unroll
                for (int n = 0; n < 2; ++n) acc[a][b][m][n] = (f32x4){0.f, 0.f, 0.f, 0.f};
    bf16x8 At[4][2], B0[2][2], B1[2][2];
    const char* cA = (const char*)g.A + (size_t)cur.pm * tstep; const char* cB = (const char*)g.Bt + (size_t)cur.pn * tstep;
    S.a_ready(cur);
    if constexpr (SP2) {
        PG8_STAGE(PG8_SB(0, 0), cB, voffB); PG8_STAGE(PG8_SB(0, 1), cB + hstepB, voffB); PG8_STAGE(PG8_SA(0, 0), cA, voffA); PG8_STAGE(PG8_SA(0, 1), cA + hstep, voffA);
        if (wr == 1) PG8_BAR;
        PG8_WAIT_V(2); PG8_BAR;
        PG8_STAGE(PG8_SB(1, 0), cB + kstep, voffB); PG8_STAGE(PG8_SA(1, 0), cA + kstep, voffA); PG8_STAGE(PG8_SB(1, 1), cB + hstepB + kstep, voffB);
        PG8_WAIT_V(6); PG8_BAR;
    } else {
        PG8_STAGE(PG8_SB(0, 0), cB, voffB); PG8_STAGE(PG8_SA(0, 0), cA, voffA); PG8_STAGE(PG8_SB(0, 1), cB + hstepB, voffB); PG8_STAGE(PG8_SA(0, 1), cA + hstep, voffA);
        if (wr == 1) PG8_BAR;
        PG8_WAIT_V(4); PG8_BAR;
        PG8_STAGE(PG8_SB(1, 0), cB + kstep, voffB); PG8_STAGE(PG8_SA(1, 0), cA + kstep, voffA); PG8_STAGE(PG8_SB(1, 1), cB + hstepB + kstep, voffB);
        PG8_WAIT_V(6); PG8_BAR;
    }
    for (;;) {
        const bool has_next = S.next(ui + 1, nxt);
        const char* nA = has_next ? (const char*)g.A + (size_t)nxt.pm * tstep : cA; const char* nB = has_next ? (const char*)g.Bt + (size_t)nxt.pn * tstep : cB;
        E.prestage(lds, cur, ui & 1, wid, lane);
        for (int t = 0; t < nt; t += 2) {
            const bool last = (t == nt - 2);
            const char* a1 = cA + (size_t)(t + 1) * kstep;
            const char* a2 = last ? nA : cA + (size_t)(t + 2) * kstep; const char* b2 = last ? nB : cB + (size_t)(t + 2) * kstep;
            const char* a3 = a2 + kstep; const char* b3 = b2 + kstep;
            if (last && has_next) S.a_ready(nxt);
            if constexpr (SP2) {
            PG8_LDB(B0, 0, 0); PG8_LDB(B1, 0, 1); PG8_SCHED; PG8_LDA(At, 0, 0); PG8_STAGE(PG8_SA(1, 1), a1 + hstep, voffA);
            PG8_WAIT_V(8); PG8_WAIT_L(0); PG8_BAR; PG8_MMA(0, 0, At, B0); PG8_MMA(0, 1, At, B1); PG8_BAR; PG8_SCHED;
            PG8_LDA(At, 0, 1); PG8_STAGE(PG8_SB(0, 0), b2, voffB); PG8_STAGE(PG8_SB(0, 1), b2 + hstepB, voffB); PG8_STAGE(PG8_SA(0, 0), a2, voffA);
            PG8_WAIT_V(8); PG8_WAIT_L(0); PG8_BAR; PG8_MMA(1, 0, At, B0); PG8_MMA(1, 1, At, B1); PG8_BAR; PG8_SCHED;
            PG8_LDB(B0, 1, 0); PG8_LDB(B1, 1, 1); PG8_SCHED; PG8_LDA(At, 1, 0); PG8_STAGE(PG8_SA(0, 1), a2 + hstep, voffA);
            PG8_WAIT_V(8); PG8_WAIT_L(0); PG8_BAR; PG8_MMA(0, 0, At, B0); PG8_MMA(0, 1, At, B1); PG8_BAR; PG8_SCHED;
            PG8_LDA(At, 1, 1); PG8_STAGE(PG8_SB(1, 0), b3, voffB); PG8_STAGE(PG8_SB(1, 1), b3 + hstepB, voffB); PG8_STAGE(PG8_SA(1, 0), a3, voffA);
            PG8_WAIT_V(8); PG8_WAIT_L(0); PG8_BAR; PG8_MMA(1, 0, At, B0); PG8_MMA(1, 1, At, B1); PG8_BAR; PG8_SCHED;
            } else {
            PG8_LDB(B0, 0, 0); PG8_SCHED; PG8_LDA(At, 0, 0); PG8_STAGE(PG8_SA(1, 1), a1 + hstep, voffA);
            PG8_WAIT_L(8); PG8_BAR; PG8_WAIT_L(0); PG8_MMA(0, 0, At, B0); PG8_BAR; PG8_SCHED;
            PG8_LDB(B1, 0, 1); PG8_STAGE(PG8_SB(0, 0), b2, voffB);
            PG8_BAR; PG8_WAIT_L(0); PG8_MMA(0, 1, At, B1); PG8_BAR;
            PG8_LDA(At, 0, 1); PG8_STAGE(PG8_SA(0, 0), a2, voffA);
            PG8_BAR; PG8_WAIT_L(0); PG8_MMA(1, 0, At, B0); PG8_BAR; PG8_SCHED;
            PG8_STAGE(PG8_SB(0, 1), b2 + hstepB, voffB);
            PG8_WAIT_V(6); PG8_BAR; PG8_MMA(1, 1, At, B1); PG8_BAR;
            PG8_LDB(B0, 1, 0); PG8_SCHED; PG8_LDA(At, 1, 0); PG8_STAGE(PG8_SA(0, 1), a2 + hstep, voffA);
            PG8_WAIT_L(8); PG8_BAR; PG8_WAIT_L(0); PG8_MMA(0, 0, At, B0); PG8_BAR; PG8_SCHED;
            PG8_LDB(B1, 1, 1); PG8_STAGE(PG8_SB(1, 0), b3, voffB);
            PG8_BAR; PG8_WAIT_L(0); PG8_MMA(0, 1, At, B1); PG8_BAR;
            PG8_LDA(At, 1, 1); PG8_STAGE(PG8_SA(1, 0), a3, voffA);
            PG8_BAR; PG8_WAIT_L(0); PG8_MMA(1, 0, At, B0); PG8_BAR; PG8_SCHED;
            PG8_STAGE(PG8_SB(1, 1), b3 + hstepB, voffB);
            PG8_WAIT_V(6); PG8_BAR; PG8_MMA(1, 1, At, B1); PG8_BAR;
            }
        }
        if constexpr (ALIGN_EPI) { if (wr == 0) PG8_BAR; }
        if constexpr (!Epi::AFTER_DRAIN) { E(acc, cur, wr, wc, fr, fq, lds + SIDE_OFF + (ui & 1) * SIDE_BYTES, lds + EPI_T_OFF + wid * EPI_T_WAVE, lane); S.done(cur); }
        if (!has_next) break;
#pragma unroll
        for (int a = 0; a < 2; ++a)
#pragma unroll
            for (int b = 0; b < 2; ++b)
#pragma unroll
                for (int m = 0; m < 4; ++m)
#pragma unroll
                    for (int n = 0; n < 2; ++n) acc[a][b][m][n] = (f32x4){0.f, 0.f, 0.f, 0.f};
        cur = nxt; cA = nA; cB = nB; ++ui;
        if constexpr (ALIGN_EPI) { if (wr == 1) PG8_BAR; }
    }
    PG8_WAIT_V(0);
    if constexpr (!ALIGN_EPI) { if (wr == 0) PG8_BAR; }
    PG8_BAR;
#undef PG8_SA
#undef PG8_SB
#undef PG8_STAGE
#undef PG8_LDA
#undef PG8_LDB
#undef PG8_MMA
#undef PG8_WAIT_V
#undef PG8_WAIT_L
#undef PG8_BAR
#undef PG8_SCHED
}
}

constexpr size_t MiB = 1u << 20;
constexpr size_t WS_CTL = 0, CTL_ZERO_BYTES = 65536;
constexpr size_t WS_SSQ = 1 * MiB, SSQ_STRIDE = (size_t)M * 8;
constexpr size_t WS_WA = 6 * MiB;
constexpr size_t WA_STRIDE = 10 * MiB, WA_QKO = 0, WA_KV = 4 * MiB, WA_G = 7 * MiB, WA_OUT = 8 * MiB;
constexpr size_t WS_WQK2 = 26 * MiB;
constexpr size_t WS_WQ3 = 30 * MiB;
constexpr size_t WS_WV = 32 * MiB;
constexpr size_t WS_WO = 34 * MiB;
constexpr size_t WS_WF = 38 * MiB;
constexpr size_t WF_STRIDE = 17 * MiB, WF_D = 11 * MiB;
constexpr size_t WS_GATES = 106 * MiB;
constexpr size_t WS_XN = 110 * MiB;
constexpr size_t WS_H = 238 * MiB;
constexpr size_t WS_BIG = 366 * MiB;
constexpr size_t WS_KVT = WS_BIG + 256 * MiB;
constexpr size_t WS_END = WS_KVT + 192 * MiB;
static_assert((4096 + 3456) * 4 <= CTL_ZERO_BYTES && WS_SSQ + 9 * SSQ_STRIDE <= WS_WA && WS_WF + 4 * WF_STRIDE <= WS_GATES && WS_GATES + (size_t)M * 16 * 4 <= WS_XN && WS_XN + (size_t)M * D * 2 <= WS_H && WS_H + (size_t)M * D * 2 <= WS_BIG, "ws map");
static_assert(WS_BIG + (size_t)M * FF * 2 <= WS_END, "ws map");

constexpr int CW_BAR = 4096;
constexpr int RING_BYTES = 131072;
constexpr int LDSCTL_OFF = RING_BYTES, MISC_OFF = LDSCTL_OFF + 320;
constexpr int LDS_BYTES = 163840;
constexpr int NWAVES = 8;

#define XB_TMO      128
#define XB_XCNT(j)  (256  + 64 * (j))
#define XB_XSUB(j)  (1280 + 64 * (j))
#define XB_XGEN(j)  (2304 + 64 * (j))
#define XB_TOP      3328
#define XB_TOPGEN   3392
#define XCD_BAR_WORDS 3456
#define XB_SPIN_CAP (1u << 18)

__device__ __forceinline__ unsigned xb_ld(unsigned* p)              { return __hip_atomic_load(p, __ATOMIC_RELAXED, __HIP_MEMORY_SCOPE_AGENT); }
__device__ __forceinline__ unsigned xb_add(unsigned* p, unsigned v) { return __hip_atomic_fetch_add(p, v, __ATOMIC_RELAXED, __HIP_MEMORY_SCOPE_AGENT); }
__device__ __forceinline__ unsigned xb_xcc_id() { return (unsigned)__builtin_amdgcn_s_getreg((3 << 11) | 20) & 0xFu; }
#define XB_SPIN(cond, bar) do { unsigned _sp = 0; while (cond) { __builtin_amdgcn_s_sleep(1); \
    if ((++_sp & 255u) == 0u) { if (xb_ld(&(bar)[XB_TMO])) break; if (_sp > XB_SPIN_CAP) { atomicAdd(&(bar)[XB_TMO], 1u); break; } } } } while (0)

struct XcdBarrier { unsigned* bar; unsigned x; volatile LAS unsigned* st; };

__device__ __forceinline__ XcdBarrier xcd_barrier_post(unsigned* bar, volatile LAS unsigned* st) {
    XcdBarrier b; b.bar = bar; b.x = xb_xcc_id(); b.st = st;
    if (threadIdx.x == 0) (void)xb_add(&bar[XB_XCNT(b.x)], 1u);
    return b;
}
__device__ __forceinline__ void xcd_barrier_complete(unsigned* bar, unsigned x, unsigned& nloc, unsigned& nx) {
    const unsigned G = gridDim.x * gridDim.y * gridDim.z;
    unsigned sum, cnt, mine, sp = 0u;
    for (;;) {
        sum = 0u; cnt = 0u; mine = 0u;
#pragma unroll
        for (unsigned j = 0; j < 16; ++j) { const unsigned c = xb_ld(&bar[XB_XCNT(j)]); sum += c; cnt += (c > 0u) ? 1u : 0u; mine = (j == x) ? c : mine; }
        if (sum == G) break;
        __builtin_amdgcn_s_sleep(1);
        if ((++sp & 255u) == 0u) { if (xb_ld(&bar[XB_TMO])) break; if (sp > XB_SPIN_CAP) { atomicAdd(&bar[XB_TMO], 1u); break; } }
    }
    nloc = mine > 0u ? mine : 1u; nx = cnt > 0u ? cnt : 1u;
}
__device__ __forceinline__ void xcd_barrier(const XcdBarrier& b) {
    asm volatile("s_waitcnt vmcnt(0)" ::: "memory");
    __syncthreads();
    if (threadIdx.x == 0) {
        unsigned* bar = b.bar;
        __builtin_amdgcn_s_waitcnt(0);
        unsigned nloc = b.st[0], nx = b.st[1];
        if (nloc == 0u) { xcd_barrier_complete(bar, b.x, nloc, nx); b.st[0] = nloc; b.st[1] = nx; }
        const unsigned old = xb_add(&bar[XB_XSUB(b.x)], 1u);
        const unsigned gen = old / nloc;
        if (old + 1u == (gen + 1u) * nloc) {
            __builtin_amdgcn_fence(__ATOMIC_RELEASE, "agent");
            asm volatile("s_waitcnt vmcnt(0)" ::: "memory");
            const unsigned og = xb_add(&bar[XB_TOP], 1u);
            const unsigned tg = og / nx;
            if (og + 1u == (tg + 1u) * nx) xb_add(&bar[XB_TOPGEN], 1u);
            else XB_SPIN(xb_ld(&bar[XB_TOPGEN]) == tg, bar);
            __builtin_amdgcn_fence(__ATOMIC_ACQUIRE, "agent");
            xb_add(&bar[XB_XGEN(b.x)], 1u);
            asm volatile("s_waitcnt vmcnt(0)" ::: "memory");
        } else {
            XB_SPIN(xb_ld(&bar[XB_XGEN(b.x)]) == gen, bar);
            __builtin_amdgcn_fence(__ATOMIC_ACQUIRE, "agent");
            asm volatile("s_waitcnt vmcnt(0)" ::: "memory");
        }
    }
    __syncthreads();
}

#define LDS_WAIT() asm volatile("s_waitcnt lgkmcnt(0)" ::: "memory")
__device__ __forceinline__ float wave_sum(float v) {
#pragma unroll
    for (int o = 1; o < 64; o <<= 1) v += __shfl_xor(v, o);
    return v;
}
__device__ __forceinline__ float xhalf_max(float x) { const auto r = __builtin_amdgcn_permlane32_swap(__float_as_uint(x), __float_as_uint(x), false, false); return fmaxf(__uint_as_float(r[0]), __uint_as_float(r[1])); }
__device__ __forceinline__ float xhalf_sum(float x) { const auto r = __builtin_amdgcn_permlane32_swap(__float_as_uint(x), __float_as_uint(x), false, false); return __uint_as_float(r[0]) + __uint_as_float(r[1]); }
__device__ __forceinline__ int crow(int reg, int hh) { return (reg & 3) + 8 * (reg >> 2) + 4 * hh; }
__device__ __forceinline__ f32x16 mfma32(bf16x8 a, bf16x8 b, f32x16 c) { return __builtin_amdgcn_mfma_f32_32x32x16_bf16(a, b, c, 0, 0, 0); }
__device__ __forceinline__ f32x16 zero16() { f32x16 z;
#pragma unroll
    for (int i = 0; i < 16; ++i) z[i] = 0.f;
    return z; }
__device__ __forceinline__ bf16x8 pack8(const f32x16& x, int s) {
    u32x4 p; p.x = pk_bf16(x[8 * s + 0], x[8 * s + 1]); p.y = pk_bf16(x[8 * s + 2], x[8 * s + 3]); p.z = pk_bf16(x[8 * s + 4], x[8 * s + 5]); p.w = pk_bf16(x[8 * s + 6], x[8 * s + 7]);
    return __builtin_bit_cast(bf16x8, p);
}
__device__ __forceinline__ bf16x8 ldperm(const bf16* p) {
    const u32x2 lo = *(const u32x2*)p, hi = *(const u32x2*)(p + 8);
    u32x4 v; v.x = lo.x; v.y = lo.y; v.z = hi.x; v.w = hi.y; return __builtin_bit_cast(bf16x8, v);
}
__device__ __forceinline__ bf16x8 ldnat(const bf16* p) { return __builtin_bit_cast(bf16x8, *(const u32x4*)p); }

struct Args { const float* in[16]; float* out; unsigned char* ws; int ph_lo, ph_hi; };
enum { I_X = 0, I_AWIN, I_ABG, I_AGH, I_AWOUT, I_BWQ, I_BREL, I_BWO, I_KVG, I_WKV, I_NMIX, I_NFFN, I_FG, I_FU, I_FD, I_FING };

struct Frame {
    LAS unsigned char* lds;
    int tid, lane, wave, G, bx;
};

struct Job { const float* src; int ldw, K, col0, ncol; bf16* dst; int drow0, inter, dperm; const float* gain; float scale; };
constexpr int NJOBS = 30;
constexpr float QSCALE = 0.125f * LOG2E;
__device__ __forceinline__ Job make_job(const Args& A, int j) {
    Job o; unsigned char* ws = A.ws;
    o.inter = -1; o.dperm = 0; o.gain = nullptr; o.scale = 1.f; o.ldw = D; o.K = D; o.col0 = 0; o.ncol = D; o.drow0 = 0; o.src = nullptr; o.dst = nullptr;
    if (j < 12) {
        const int l = j / 6, t = j % 6;
        unsigned char* wb = ws + WS_WA + (size_t)l * WA_STRIDE;
        if (t < 5) {
            o.src = A.in[I_AWIN] + (size_t)l * D * AIN; o.ldw = AIN; o.gain = A.in[I_NMIX] + l * D;
            if (t == 0) { o.col0 = 0; o.ncol = 512; o.dst = (bf16*)(wb + WA_QKO); o.drow0 = 0; }
            else if (t == 1) { o.col0 = 512; o.ncol = 512; o.dst = (bf16*)(wb + WA_QKO); o.drow0 = 512; o.scale = 0.125f; }
            else if (t == 2) { o.col0 = 2048; o.ncol = 1024; o.dst = (bf16*)(wb + WA_QKO); o.drow0 = 1024; }
            else if (t == 3) { o.col0 = 512; o.ncol = 0; o.dst = (bf16*)(wb + WA_KV); o.drow0 = 0; }
            else { o.col0 = 1024; o.ncol = 1024; o.dst = (bf16*)(wb + WA_KV); o.drow0 = 0; }
        } else { o.src = A.in[I_AWOUT] + (size_t)l * D * D; o.dst = (bf16*)(wb + WA_OUT); }
    } else if (j < 18) {
        const int t = j - 12;
        if (t == 0) { o.src = A.in[I_BWQ]; o.dst = (bf16*)(ws + WS_WQK2); o.gain = A.in[I_NMIX] + 2 * D; o.scale = QSCALE; }
        else if (t == 1) { o.src = A.in[I_WKV]; o.ldw = 2 * D; o.col0 = 0; o.dst = (bf16*)(ws + WS_WQK2); o.drow0 = 1024; o.gain = A.in[I_KVG]; }
        else if (t == 2) { o.src = A.in[I_WKV]; o.ldw = 2 * D; o.col0 = 1024; o.dst = (bf16*)(ws + WS_WV); o.gain = A.in[I_KVG]; }
        else if (t == 3) { o.src = A.in[I_BWQ] + (size_t)D * D; o.dst = (bf16*)(ws + WS_WQ3); o.gain = A.in[I_NMIX] + 3 * D; o.scale = QSCALE; }
        else if (t == 4) { o.src = A.in[I_BWO]; o.dst = (bf16*)(ws + WS_WO); }
        else { o.src = A.in[I_BWO] + (size_t)D * D; o.dst = (bf16*)(ws + WS_WO + 2 * MiB); }
    } else {
        const int l = (j - 18) / 3, t = (j - 18) % 3;
        unsigned char* wb = ws + WS_WF + (size_t)l * WF_STRIDE;
        if (t == 0) { o.src = A.in[I_FG] + (size_t)l * D * FF; o.ldw = FF; o.ncol = FF; o.dst = (bf16*)wb; o.inter = 0; o.gain = A.in[I_NFFN] + l * D; }
        else if (t == 1) { o.src = A.in[I_FU] + (size_t)l * D * FF; o.ldw = FF; o.ncol = FF; o.dst = (bf16*)wb; o.inter = 1; o.gain = A.in[I_NFFN] + l * D; }
        else { o.src = A.in[I_FD] + (size_t)l * FF * D; o.ldw = D; o.K = FF; o.ncol = D; o.dst = (bf16*)(wb + WF_D); }
    }
    return o;
}
__device__ __forceinline__ void p0_transpose_item(const Job& jb, LAS float* scr, int item, int lane) {
    const int nblk = jb.ncol / 32, kb = item / nblk, nb = item % nblk, k0 = 64 * kb, n0 = 32 * nb;
    const float* W = jb.src + jb.col0 + n0;
    f32x4 wv[8];
#pragma unroll
    for (int i = 0; i < 8; ++i) wv[i] = __builtin_nontemporal_load((const f32x4*)(W + (size_t)(k0 + 8 * i + (lane >> 3)) * jb.ldw + 4 * (lane & 7)));
#pragma unroll
    for (int i = 0; i < 8; ++i) { const int kk = 8 * i + (lane >> 3); const float gg = (jb.gain ? jb.gain[k0 + kk] : 1.f) * jb.scale; LAS float* d = scr + kk * 33 + 4 * (lane & 7);
        d[0] = wv[i].x * gg; d[1] = wv[i].y * gg; d[2] = wv[i].z * gg; d[3] = wv[i].w * gg; }
    LDS_WAIT(); asm volatile("" ::: "memory");
    const int c = lane & 7;
    const int drow = jb.drow0 + (jb.inter >= 0 ? 256 * (n0 >> 7) + 128 * jb.inter + (n0 & 127) : n0);
#pragma unroll
    for (int j = 0; j < 4; ++j) { const int n = (lane >> 3) + 8 * j; const LAS float* s = scr + (8 * c) * 33 + n;
        const int nd = jb.dperm ? ((n & ~15) | ((n & 3) | ((n & 4) << 1) | ((n & 8) >> 1))) : n;
        u32x4 o; o.x = pk_bf16(s[0 * 33], s[1 * 33]); o.y = pk_bf16(s[2 * 33], s[3 * 33]); o.z = pk_bf16(s[4 * 33], s[5 * 33]); o.w = pk_bf16(s[6 * 33], s[7 * 33]);
        *(u32x4*)(jb.dst + (size_t)(drow + nd) * jb.K + k0 + 8 * c) = o; }
    LDS_WAIT(); asm volatile("" ::: "memory");
}
__device__ __forceinline__ void p0_prologue(const Frame& F, const Args& A) {
    LAS float* scr = (LAS float*)(F.lds + F.wave * 16384);
    const int gw = F.bx * NWAVES + F.wave, NGW = F.G * NWAVES;
    int off = 0;
    for (int j = 0; j < NJOBS; ++j) {
        const Job jb = make_job(A, j);
        const int n = (jb.K / 64) * (jb.ncol / 32);
        int first = (gw - off) % NGW; if (first < 0) first += NGW;
        for (int r = first; r < n; r += NGW) p0_transpose_item(jb, scr, r, F.lane);
        off += n;
    }
    for (int e = (F.bx * NWAVES * 64 + F.tid); e < 2 * 16 * D; e += F.G * NWAVES * 64) {
        const int l = e / (16 * D), j = (e / D) % 16, k = e % D;
        const float w = A.in[I_AWIN][(size_t)l * D * AIN + (size_t)k * AIN + 3072 + j] * A.in[I_NMIX][l * D + k];
        ((bf16*)(A.ws + WS_WA + (size_t)l * WA_STRIDE + WA_G))[j * D + k] = (bf16)(pk_bf16(w, 0.f) & 0xffffu);
    }
}

__device__ __forceinline__ void xconv_phase(const Frame& F, const float* x, bf16* h, u64* ssq) {
    const int gw = F.bx * NWAVES + F.wave, NGW = F.G * NWAVES;
    for (int m = gw; m < M; m += NGW) {
        const f32x4* xr = (const f32x4*)(x + (size_t)m * D) + F.lane;
        f32x4 v[4]; float s = 0.f;
#pragma unroll
        for (int j = 0; j < 4; ++j) { v[j] = __builtin_nontemporal_load(xr + 64 * j); s += (v[j].x * v[j].x + v[j].y * v[j].y) + (v[j].z * v[j].z + v[j].w * v[j].w); }
        s = wave_sum(s);
        if (F.lane == 0) ssq[m] = (u64)(s * SSQ_FIX);
        u32x2* o8 = (u32x2*)(h + (size_t)m * D) + F.lane;
#pragma unroll
        for (int j = 0; j < 4; ++j) { u32x2 w; w.x = pk_bf16(v[j].x, v[j].y); w.y = pk_bf16(v[j].z, v[j].w); o8[64 * j] = w; }
    }
}
__device__ __forceinline__ void final_norm_phase(const Frame& F, const bf16* h, const u64* ssq, const float* g, float* out) {
    const int gw = F.bx * NWAVES + F.wave, NGW = F.G * NWAVES;
    f32x4 gv[4];
#pragma unroll
    for (int j = 0; j < 2; ++j) { gv[2 * j] = *(const f32x4*)(g + 512 * j + 8 * F.lane); gv[2 * j + 1] = *(const f32x4*)(g + 512 * j + 8 * F.lane + 4); }
    for (int m = gw; m < M; m += NGW) {
        const bf16* hr = h + (size_t)m * D + 8 * F.lane;
        const u32x4 h0 = __builtin_nontemporal_load((const u32x4*)hr), h1 = __builtin_nontemporal_load((const u32x4*)(hr + 512));
        const float rstd = 1.f / sqrtf((float)ssq[m] * (1.0f / (1048576.0f * 1024.0f)) + EPS);
        float* orow = out + (size_t)m * D + 8 * F.lane;
        f32x4 v;
        v.x = bf_lo(h0.x); v.y = bf_hi(h0.x); v.z = bf_lo(h0.y); v.w = bf_hi(h0.y); __builtin_nontemporal_store(v * rstd * gv[0], (f32x4*)(orow));
        v.x = bf_lo(h0.z); v.y = bf_hi(h0.z); v.z = bf_lo(h0.w); v.w = bf_hi(h0.w); __builtin_nontemporal_store(v * rstd * gv[1], (f32x4*)(orow + 4));
        v.x = bf_lo(h1.x); v.y = bf_hi(h1.x); v.z = bf_lo(h1.y); v.w = bf_hi(h1.y); __builtin_nontemporal_store(v * rstd * gv[2], (f32x4*)(orow + 512));
        v.x = bf_lo(h1.z); v.y = bf_hi(h1.z); v.z = bf_lo(h1.w); v.w = bf_hi(h1.w); __builtin_nontemporal_store(v * rstd * gv[3], (f32x4*)(orow + 516));
    }
}

__device__ __forceinline__ void gates_phase(const Frame& F, const bf16* h, const u64* ssq, const bf16* wg, const float* bgate, float* gt) {
    const int gw = F.bx * NWAVES + F.wave, NGW = F.G * NWAVES;
    int lane_ = F.lane; asm volatile("" : "+v"(lane_));
    const int r16 = lane_ & 15, kg = lane_ >> 4;
    const float bias = bgate[r16];
    for (int it = gw; it < M / 16; it += NGW) {
        const bf16* ap = h + (size_t)(it * 16 + r16) * D + 8 * kg;
        const bf16* bp = wg + (size_t)r16 * D + 8 * kg;
        f32x4 acc = {0.f, 0.f, 0.f, 0.f};
#pragma unroll 8
        for (int s = 0; s < D / 32; ++s) acc = __builtin_amdgcn_mfma_f32_16x16x32_bf16(ldnat(ap + 32 * s), ldnat(bp + 32 * s), acc, 0, 0, 0);
        f32x4 o;
#pragma unroll
        for (int e = 0; e < 4; ++e) o[e] = acc[e] * rstd_of(ssq[it * 16 + 4 * kg + e]) + bias;
        *(f32x4*)(gt + (size_t)r16 * M + it * 16 + 4 * kg) = o;
    }
}

typedef short v4i16_t __attribute__((ext_vector_type(4)));
constexpr int ML_Q = 0, ML_K = 8192, ML_VT = 16384, ML_OP = 32768, ML_BUF = 49152;
constexpr int ML_KS = 2 * ML_BUF, ML_SCR = ML_KS + 8192, ML_SSQ = ML_SCR + 8192;
constexpr int ML_OT = pg8::EPI_T_OFF;
static_assert(ML_SSQ + 2048 + 512 <= RING_BYTES && ML_OT + 8 * 32 * 80 <= 163840, "mLSTM LDS map");
__device__ __forceinline__ void mlstm_phase(const Frame& F, const bf16* qko, const bf16* vtg, const float* gates, const float* ghead, bf16* hs) {
    int lane_ = F.lane; asm volatile("" : "+v"(lane_));
    const int w = F.wave, lane = lane_, r = lane & 31, hh = lane >> 5, vblk = w & 3, tblk = w >> 2;
    LAS float* Gs = (LAS float*)(F.lds + ML_SCR + w * 1024);
    LAS float* WAs = Gs + 64;
    LAS float* SSQ = (LAS float*)(F.lds + ML_SSQ);
    const int xs = (r >> 1) & 7;
    const int foff0 = r * 128 + (((0 + hh) ^ xs) << 4), foff1 = r * 128 + (((2 + hh) ^ xs) << 4), foff2 = r * 128 + (((4 + hh) ^ xs) << 4), foff3 = r * 128 + (((6 + hh) ^ xs) << 4);
    const int qpo0 = r * 128 + 8 * hh;
    const int tq = (lane & 15) >> 2, tp = lane & 3, tg = (lane >> 4) & 1;
    const int t = 32 * tblk + r;
    const bf16x8 ONES = __builtin_bit_cast(bf16x8, (u32x4){0x3F803F80u, 0x3F803F80u, 0x3F803F80u, 0x3F803F80u});
#define ML_DMA(g_, off_) __builtin_amdgcn_global_load_lds((const unsigned*)(g_), (LAS unsigned*)(bufp + (off_)), 16, 0, 0)
#define ML_ISSUE(cc_) do { const size_t tk_ = (size_t)b * SEQ + (size_t)(cc_) * CH; LAS unsigned char* bufp = F.lds + ((cc_) & 1) * ML_BUF + w * 1024; \
        int l2_ = lane; asm volatile("" : "+v"(l2_));        \
        const int r8_ = 8 * w + (l2_ >> 3), c8_ = (l2_ & 7) ^ ((r8_ >> 1) & 7), r4a_ = 4 * w + (l2_ >> 4), c4a_ = (l2_ & 15) ^ (r4a_ & 15), r4b_ = r4a_ + 32, c4b_ = (l2_ & 15) ^ (r4b_ & 15); \
        ML_DMA(qko + (tk_ + r8_) * 2048 + h * DQK + c8_ * 8, ML_Q); \
        ML_DMA(qko + (tk_ + r8_) * 2048 + 512 + h * DQK + c8_ * 8, ML_K); \
        ML_DMA(vtg + (size_t)(h * DV + r8_) * M + tk_ + c8_ * 8, ML_VT); \
        ML_DMA(vtg + (size_t)(h * DV + 64 + r8_) * M + tk_ + c8_ * 8, ML_VT + 8192); \
        ML_DMA(qko + (tk_ + r4a_) * 2048 + 1024 + h * DV + c4a_ * 8, ML_OP); \
        ML_DMA(qko + (tk_ + r4b_) * 2048 + 1024 + h * DV + c4b_ * 8, ML_OP + 8192); } while (0)
#define ML_FRAG(off_) (*(const LAS bf16x8*)(buf + (off_)))
    for (int bh = F.bx; bh < NBATCH * AH; bh += F.G) {
        const int b = bh / AH, h = bh % AH;
        asm volatile("s_waitcnt vmcnt(0) lgkmcnt(0)" ::: "memory"); __builtin_amdgcn_s_barrier(); asm volatile("" ::: "memory");
        f32x16 Ct0 = zero16(), Ct1 = zero16(), Nt0 = zero16(), Nt1 = zero16();
        float m_state = -1e30f;
        LAS float* GH = (LAS float*)(F.lds + ML_SSQ + 2048);
        if (F.tid < DV) GH[F.tid] = ghead[h * DV + F.tid];
        const float* gi = gates + (size_t)h * M + (size_t)b * SEQ + lane; const float* gf = gates + (size_t)(8 + h) * M + (size_t)b * SEQ + lane;
        float ipre_n = gi[0], fpre_n = gf[0];
        ML_ISSUE(0);
        for (int c = 0; c < NCH; ++c) {
            const size_t tok0 = (size_t)b * SEQ + (size_t)c * CH;
            const LAS unsigned char* buf = F.lds + (c & 1) * ML_BUF;
            const float ipre = ipre_n * LOG2E, fpre = fpre_n;
            const float flog = (fminf(fpre, 0.f) - __logf(1.f + __expf(-fabsf(fpre)))) * LOG2E;
            float bc = flog;
#pragma unroll
            for (int o = 1; o < 64; o <<= 1) { const float tv = __shfl_up(bc, o); if (lane >= o) bc += tv; }
            const float gs = ipre - bc;
            float pm = gs;
#pragma unroll
            for (int o = 1; o < 64; o <<= 1) { const float tv = __shfl_up(pm, o); if (lane >= o) pm = fmaxf(pm, tv); }
            const float Mt = fmaxf(m_state, pm);
            const float bL = __shfl(bc, 63), M63 = __shfl(Mt, 63);
            const float wa = fast_exp2(gs - M63);
            const float decay = fast_exp2(m_state - M63);
            const float wint_l = fast_exp2(m_state - Mt), floor_l = fast_exp2(-bc - Mt);
            Gs[lane] = gs; WAs[lane] = wa;
            const float Mt_t = __shfl(Mt, t), wint = __shfl(wint_l, t), floorv = __shfl(floor_l, t);
            asm volatile("s_waitcnt vmcnt(0) lgkmcnt(0)" ::: "memory"); __builtin_amdgcn_s_barrier(); asm volatile("" ::: "memory");
            if (c + 1 < NCH) { ipre_n = gi[(c + 1) * CH]; fpre_n = gf[(c + 1) * CH]; ML_ISSUE(c + 1); }
            {
                const u32x4 kraw = *(const LAS u32x4*)(buf + ML_K + w * 1024 + lane * 16);
                const float was = WAs[8 * w + (lane >> 3)];
                u32x4 ko; ko.x = pk_bf16(bf_lo(kraw.x) * was, bf_hi(kraw.x) * was); ko.y = pk_bf16(bf_lo(kraw.y) * was, bf_hi(kraw.y) * was);
                ko.z = pk_bf16(bf_lo(kraw.z) * was, bf_hi(kraw.z) * was); ko.w = pk_bf16(bf_lo(kraw.w) * was, bf_hi(kraw.w) * was);
                *(LAS u32x4*)(F.lds + ML_KS + w * 1024 + lane * 16) = ko;
            }
            const bf16x8 qf0 = ML_FRAG(ML_Q + tblk * 4096 + foff0), qf1 = ML_FRAG(ML_Q + tblk * 4096 + foff1), qf2 = ML_FRAG(ML_Q + tblk * 4096 + foff2), qf3 = ML_FRAG(ML_Q + tblk * 4096 + foff3);
            f32x16 S0 = zero16(), S1 = zero16();
            S0 = mfma32(ML_FRAG(ML_K + foff0), qf0, S0); S0 = mfma32(ML_FRAG(ML_K + foff1), qf1, S0); S0 = mfma32(ML_FRAG(ML_K + foff2), qf2, S0); S0 = mfma32(ML_FRAG(ML_K + foff3), qf3, S0);
            if (tblk == 1) { S1 = mfma32(ML_FRAG(ML_K + 4096 + foff0), qf0, S1); S1 = mfma32(ML_FRAG(ML_K + 4096 + foff1), qf1, S1); S1 = mfma32(ML_FRAG(ML_K + 4096 + foff2), qf2, S1); S1 = mfma32(ML_FRAG(ML_K + 4096 + foff3), qf3, S1); }
            if (tblk == 0) {
#pragma unroll
                for (int g4 = 0; g4 < 4; ++g4) { const f32x4 ga = *(const LAS f32x4*)(Gs + 8 * g4 + 4 * hh);
#pragma unroll
                    for (int e = 0; e < 4; ++e) { const int s0 = 8 * g4 + 4 * hh + e; S0[4 * g4 + e] = (s0 <= t) ? S0[4 * g4 + e] * fast_exp2(ga[e] - Mt_t) : 0.f; } }
            } else {
#pragma unroll
                for (int g4 = 0; g4 < 4; ++g4) { const f32x4 ga = *(const LAS f32x4*)(Gs + 8 * g4 + 4 * hh); const f32x4 gb = *(const LAS f32x4*)(Gs + 32 + 8 * g4 + 4 * hh);
#pragma unroll
                    for (int e = 0; e < 4; ++e) { const int s1 = 32 + 8 * g4 + 4 * hh + e; S0[4 * g4 + e] = S0[4 * g4 + e] * fast_exp2(ga[e] - Mt_t);
                        S1[4 * g4 + e] = (s1 <= t) ? S1[4 * g4 + e] * fast_exp2(gb[e] - Mt_t) : 0.f; } }
            }
            const bf16x8 p0 = pack8(S0, 0), p1 = pack8(S0, 1), p2 = pack8(S1, 0), p3 = pack8(S1, 1);
            __builtin_amdgcn_sched_barrier(0);
            float den;
            { f32x16 accs = zero16();
              accs = mfma32(ONES, p0, accs); accs = mfma32(ONES, p1, accs);
              if (tblk == 1) { accs = mfma32(ONES, p2, accs); accs = mfma32(ONES, p3, accs); }
              den = accs[0]; }
            bf16x8 qp[4];
#pragma unroll
            for (int f = 0; f < 4; ++f) { const u32x2 lo = *(const LAS u32x2*)(buf + ML_Q + tblk * 4096 + qpo0 + (((2 * f) ^ xs) << 4)), hi = *(const LAS u32x2*)(buf + ML_Q + tblk * 4096 + qpo0 + (((2 * f + 1) ^ xs) << 4));
                u32x4 v; v.x = lo.x; v.y = lo.y; v.z = hi.x; v.w = hi.y; qp[f] = __builtin_bit_cast(bf16x8, v); }
            { f32x16 accd = zero16();
              accd = mfma32(pack8(Nt0, 0), qp[0], accd); accd = mfma32(pack8(Nt0, 1), qp[1], accd); accd = mfma32(pack8(Nt1, 0), qp[2], accd); accd = mfma32(pack8(Nt1, 1), qp[3], accd);
              den += accd[0] * wint; }
            __builtin_amdgcn_sched_barrier(0);
            f32x16 acc = zero16();
            acc = mfma32(pack8(Ct0, 0), qp[0], acc); acc = mfma32(pack8(Ct0, 1), qp[1], acc); acc = mfma32(pack8(Ct1, 0), qp[2], acc); acc = mfma32(pack8(Ct1, 1), qp[3], acc);
#pragma unroll
            for (int i = 0; i < 16; ++i) acc[i] *= wint;
            __builtin_amdgcn_sched_barrier(0);
            { const bf16x8 vf0 = ML_FRAG(ML_VT + vblk * 4096 + foff0), vf1 = ML_FRAG(ML_VT + vblk * 4096 + foff1);
              acc = mfma32(vf0, p0, acc); acc = mfma32(vf1, p1, acc); }
            if (tblk == 1) { const bf16x8 vf2 = ML_FRAG(ML_VT + vblk * 4096 + foff2), vf3 = ML_FRAG(ML_VT + vblk * 4096 + foff3); acc = mfma32(vf2, p2, acc); acc = mfma32(vf3, p3, acc); }
            const float inv = 1.f / fmaxf(fabsf(den), floorv);
            float sq = 0.f;
#pragma unroll
            for (int i = 0; i < 16; ++i) { acc[i] *= inv; sq += acc[i] * acc[i]; }
            sq = xhalf_sum(sq);
            LAS float* sqp = SSQ + (c & 1) * 256;
            if (hh == 0) sqp[vblk * 64 + t] = sq;
            asm volatile("s_waitcnt lgkmcnt(0)" ::: "memory"); __builtin_amdgcn_s_barrier(); asm volatile("" ::: "memory");
            const float tot = (sqp[t] + sqp[64 + t]) + (sqp[128 + t] + sqp[192 + t]);
            const float rinv = __builtin_amdgcn_rsqf(tot * (1.f / DV) + EPS);
            LAS unsigned char* otw = F.lds + ML_OT + w * (32 * 80) + r * 80 + 8 * hh;
#pragma unroll
            for (int gq = 0; gq < 4; ++gq) {
                const u32x4 ov4 = *(const LAS u32x4*)(buf + ML_OP + t * 256 + (((4 * vblk + gq) ^ (t & 15)) << 4));
                const f32x4 ghv = *(const LAS f32x4*)(GH + 32 * vblk + 8 * gq + 4 * hh);
                const unsigned ox = hh ? ov4.z : ov4.x, oy = hh ? ov4.w : ov4.y;
                const float o0 = bf_lo(ox), o1 = bf_hi(ox), o2 = bf_lo(oy), o3 = bf_hi(oy);
                const float y0 = acc[4 * gq + 0] * rinv * ghv[0] * fast_rcp(1.f + fast_exp(-o0));
                const float y1 = acc[4 * gq + 1] * rinv * ghv[1] * fast_rcp(1.f + fast_exp(-o1));
                const float y2 = acc[4 * gq + 2] * rinv * ghv[2] * fast_rcp(1.f + fast_exp(-o2));
                const float y3 = acc[4 * gq + 3] * rinv * ghv[3] * fast_rcp(1.f + fast_exp(-o3));
                u32x2 wv; wv.x = pk_bf16(y0, y1); wv.y = pk_bf16(y2, y3);
                *(LAS u32x2*)(otw + 16 * gq) = wv;
            }
            asm volatile("s_waitcnt lgkmcnt(0)" ::: "memory");
            {
                const LAS unsigned char* otr = F.lds + ML_OT + w * (32 * 80) + (lane >> 2) * 80 + (lane & 3) * 16;
                bf16* hp = hs + (tok0 + 32 * tblk + (lane >> 2)) * D + h * DV + 32 * vblk + 8 * (lane & 3);
                const u32x4 oa = *(const LAS u32x4*)otr, ob = *(const LAS u32x4*)(otr + 16 * 80);
                *(u32x4*)hp = oa; *(u32x4*)(hp + (size_t)16 * D) = ob;
            }
#pragma unroll
            for (int i = 0; i < 16; ++i) { Ct0[i] *= decay; Ct1[i] *= decay; Nt0[i] *= decay; Nt1[i] *= decay; }
            {
                const bf16x8 vfs[4] = {ML_FRAG(ML_VT + vblk * 4096 + foff0), ML_FRAG(ML_VT + vblk * 4096 + foff1), ML_FRAG(ML_VT + vblk * 4096 + foff2), ML_FRAG(ML_VT + vblk * 4096 + foff3)};
                const LAS unsigned char* ks = F.lds + ML_KS;
#pragma unroll
                for (int db = 0; db < 2; ++db) {
#pragma unroll
                    for (int f = 0; f < 4; ++f) {
                        const int sa = 16 * f + 4 * hh + tq, sb2 = sa + 8, ch = 4 * db + 2 * tg + (tp >> 1);
                        const v4i16_t lo = __builtin_amdgcn_ds_read_tr16_b64_v4i16((LAS v4i16_t*)(ks + sa * 128 + ((ch ^ ((sa >> 1) & 7)) << 4) + 8 * (tp & 1)));
                        const v4i16_t hi = __builtin_amdgcn_ds_read_tr16_b64_v4i16((LAS v4i16_t*)(ks + sb2 * 128 + ((ch ^ ((sb2 >> 1) & 7)) << 4) + 8 * (tp & 1)));
                        const bf16x8 kf = __builtin_shufflevector(lo, hi, 0, 1, 2, 3, 4, 5, 6, 7);
                        if (db == 0) { Ct0 = mfma32(kf, vfs[f], Ct0); Nt0 = mfma32(kf, ONES, Nt0); } else { Ct1 = mfma32(kf, vfs[f], Ct1); Nt1 = mfma32(kf, ONES, Nt1); }
                    }
                }
            }
            m_state = bL + M63;
        }
        asm volatile("s_waitcnt vmcnt(0) lgkmcnt(0)" ::: "memory"); __builtin_amdgcn_s_barrier(); asm volatile("" ::: "memory");
    }
#undef ML_DMA
#undef ML_ISSUE
#undef ML_FRAG
}

constexpr int AT_TBL = 0, AT_TBLN = 832;
constexpr int AT_RING = 8192, AT_SLOT = 16384, AT_QOFF = AT_RING + 3 * AT_SLOT;
constexpr int AT_STEPS = 84;
__device__ __forceinline__ void attn_decode(int rem, int& cg, int& kc) {
    if (rem < 4) { cg = 0; kc = rem; } else if (rem < 12) { cg = 1; kc = rem - 4; } else { const int q = (rem - 12) / 12; cg = 2 + q; kc = 4 * cg - 8 + (rem - 12) - 12 * q; }
}
__device__ __forceinline__ void attn_phase(const Frame& F, const bf16* qb, const bf16* kb, const bf16* vt, const float* rel, bf16* ao) {
    int lane_ = F.lane; asm volatile("" : "+v"(lane_));
    const int w = F.wave, lane = lane_, r = lane & 31, hh = lane >> 5, half = w & 1, co = w >> 1;
    LAS float* TB = (LAS float*)(F.lds + AT_TBL);
    LAS unsigned char* ringp = F.lds + AT_RING;
    const int P = w * 64 + lane, srow = P >> 3, scol = (P & 7) ^ ((srow >> 1) & 7);
    const int xs = (r >> 1) & 7;
    const int foff0 = r * 128 + (((0 + hh) ^ xs) << 4), foff1 = r * 128 + (((2 + hh) ^ xs) << 4), foff2 = r * 128 + (((4 + hh) ^ xs) << 4), foff3 = r * 128 + (((6 + hh) ^ xs) << 4);
    const int t = 32 * half + r;
    constexpr int NS = 2 * AT_STEPS;
#define AT_ISSUE(n_) do { const int nn_ = (n_) < NS ? (n_) : NS - 1; const int pi_ = nn_ / AT_STEPS; int cg_, kc_; attn_decode(nn_ - pi_ * AT_STEPS, cg_, kc_); \
        const int bh_ = 2 * pr + pi_, b_ = bh_ / BH, hd_ = bh_ % BH; const size_t kt_ = (size_t)b_ * SEQ + (size_t)kc_ * CH; \
        const bf16* gk_ = kb + (kt_ + srow) * D + hd_ * DHD + scol * 8; const bf16* gv_ = vt + (size_t)(hd_ * DHD + srow) * M + kt_ + scol * 8; \
        LAS unsigned char* dst_ = ringp + ((n_) % 3) * AT_SLOT + w * 1024; \
        __builtin_amdgcn_global_load_lds((const unsigned*)gk_, (LAS unsigned*)dst_, 16, 0, 0); \
        __builtin_amdgcn_global_load_lds((const unsigned*)gv_, (LAS unsigned*)(dst_ + 8192), 16, 0, 0); } while (0)
#define AT_QDMA(pi_, cg_) do { const int bh_ = 2 * pr + (pi_), b_ = bh_ / BH, hd_ = bh_ % BH; \
        const bf16* qp_ = qb + ((size_t)b_ * SEQ + (size_t)(4 * (cg_) + co) * CH + 32 * half) * D + hd_ * DHD; \
        _Pragma("unroll") for (int i_ = 0; i_ < 4; ++i_) { const int row_ = 8 * i_ + (lane >> 3), col_ = (lane & 7) ^ ((row_ >> 1) & 7); \
            __builtin_amdgcn_global_load_lds((const unsigned*)(qp_ + (size_t)row_ * D + col_ * 8), (LAS unsigned*)(qlds + i_ * 1024), 16, 0, 0); } } while (0)
    LAS unsigned char* qlds = F.lds + AT_QOFF + w * 4096;
    LAS unsigned char* otl = F.lds + AT_QOFF + 8 * 4096 + w * (32 * 144);
    for (int pr = F.bx; pr < NBATCH * BH / 2; pr += F.G) {
        asm volatile("s_waitcnt vmcnt(0) lgkmcnt(0)" ::: "memory"); __builtin_amdgcn_s_barrier(); asm volatile("" ::: "memory");
        for (int e = F.tid; e < 2 * AT_TBLN; e += NWAVES * 64) { const int pi = e / AT_TBLN, ix = e % AT_TBLN; const int hd = (2 * pr + pi) % BH; TB[e] = rel[hd * NREL + (ix < 512 ? ix : 512)] * LOG2E; }
        asm volatile("s_waitcnt vmcnt(0) lgkmcnt(0)" ::: "memory"); __builtin_amdgcn_s_barrier(); asm volatile("" ::: "memory");
        AT_QDMA(0, 0);
        asm volatile("s_waitcnt vmcnt(0)" ::: "memory");
        AT_ISSUE(0); AT_ISSUE(1);
        bf16x8 qf[4];
        f32x16 O0 = zero16(), O1 = zero16();
        float m_run = 0.f, lsum = 0.f;
        for (int n = 0; n < NS; ++n) {
            const int pi = n / AT_STEPS; int cg, kc; attn_decode(n - pi * AT_STEPS, cg, kc);
            const int c = 4 * cg + co;
            asm volatile("s_waitcnt vmcnt(2)" ::: "memory"); __builtin_amdgcn_s_barrier(); asm volatile("" ::: "memory");
            AT_ISSUE(n + 2);
            const int kfirst = c < 8 ? 0 : c - 8;
            if (kc == kfirst) {
                qf[0] = *(const LAS bf16x8*)(qlds + foff0); qf[1] = *(const LAS bf16x8*)(qlds + foff1); qf[2] = *(const LAS bf16x8*)(qlds + foff2); qf[3] = *(const LAS bf16x8*)(qlds + foff3);
                O0 = zero16(); O1 = zero16(); m_run = 0.f; lsum = 0.f;
                int npi = pi, ncg = cg + 1; if (ncg == 8) { ncg = 0; npi = pi + 1; }
                asm volatile("s_waitcnt lgkmcnt(0)" ::: "memory");
                if (npi < 2) AT_QDMA(npi, ncg);
            }
            if (kc >= kfirst && kc <= c) {
                const int j = kc - (c - 8);
                const LAS float* tb = TB + pi * AT_TBLN;
                const LAS unsigned char* sl = ringp + (n % 3) * AT_SLOT;
                const LAS unsigned char* a0 = sl + foff0; const LAS unsigned char* a1 = sl + foff1; const LAS unsigned char* a2 = sl + foff2; const LAS unsigned char* a3 = sl + foff3;
                bf16x8 kf0 = *(const LAS bf16x8*)(a0), kf1 = *(const LAS bf16x8*)(a1), kf2 = *(const LAS bf16x8*)(a2), kf3 = *(const LAS bf16x8*)(a3);
                bf16x8 kf4 = *(const LAS bf16x8*)(a0 + 4096), kf5 = *(const LAS bf16x8*)(a1 + 4096), kf6 = *(const LAS bf16x8*)(a2 + 4096), kf7 = *(const LAS bf16x8*)(a3 + 4096);
                f32x16 S0, S1;
                {
                    const LAS float* pb = tb + ((8 - j) * 64 + t + 256 - 63 - 4 * hh);
#pragma unroll
                    for (int i = 0; i < 16; ++i) { const int ci = (i & 3) + 8 * (i >> 2); S0[i] = pb[63 - ci]; S1[i] = pb[63 - ci - 32]; }
                }
                asm volatile("" : "+v"(kf0), "+v"(kf1), "+v"(kf2), "+v"(kf3), "+v"(kf4), "+v"(kf5), "+v"(kf6), "+v"(kf7), "+v"(S0), "+v"(S1));
                S0 = mfma32(kf0, qf[0], S0); S1 = mfma32(kf4, qf[0], S1); S0 = mfma32(kf1, qf[1], S0); S1 = mfma32(kf5, qf[1], S1);
                S0 = mfma32(kf2, qf[2], S0); S1 = mfma32(kf6, qf[2], S1); S0 = mfma32(kf3, qf[3], S0); S1 = mfma32(kf7, qf[3], S1);
                bf16x8 vf0 = *(const LAS bf16x8*)(a0 + 8192), vf1 = *(const LAS bf16x8*)(a1 + 8192), vf2 = *(const LAS bf16x8*)(a2 + 8192), vf3 = *(const LAS bf16x8*)(a3 + 8192);
                bf16x8 vf4 = *(const LAS bf16x8*)(a0 + 12288), vf5 = *(const LAS bf16x8*)(a1 + 12288), vf6 = *(const LAS bf16x8*)(a2 + 12288), vf7 = *(const LAS bf16x8*)(a3 + 12288);
                __builtin_amdgcn_sched_barrier(0);
                float mx = -3.0e38f;
#pragma unroll
                for (int i = 0; i < 16; ++i) { S0[i] -= m_run; S1[i] -= m_run; mx = fmaxf(mx, fmaxf(S0[i], S1[i])); }
                mx = xhalf_max(mx);
                const bool first = (kc == kfirst);
                if (first || __any(mx > 8.0f)) {
                    const float dm = first ? mx : (mx > 8.0f ? mx : 0.f);
                    const float alpha = first ? 0.f : fast_exp2(-dm);
                    m_run += dm; lsum *= alpha;
#pragma unroll
                    for (int i = 0; i < 16; ++i) { O0[i] *= alpha; O1[i] *= alpha; S0[i] -= dm; S1[i] -= dm; }
                }
                float ps = 0.f;
#pragma unroll
                for (int i = 0; i < 16; ++i) { S0[i] = fast_exp2(S0[i]); S1[i] = fast_exp2(S1[i]); ps += S0[i] + S1[i]; }
                lsum += ps;
                const bf16x8 p0 = pack8(S0, 0), p1 = pack8(S0, 1), p2 = pack8(S1, 0), p3 = pack8(S1, 1);
                asm volatile("" : "+v"(vf0), "+v"(vf1), "+v"(vf2), "+v"(vf3), "+v"(vf4), "+v"(vf5), "+v"(vf6), "+v"(vf7));
                O0 = mfma32(vf0, p0, O0); O1 = mfma32(vf4, p0, O1); O0 = mfma32(vf1, p1, O0); O1 = mfma32(vf5, p1, O1);
                O0 = mfma32(vf2, p2, O0); O1 = mfma32(vf6, p2, O1); O0 = mfma32(vf3, p3, O0); O1 = mfma32(vf7, p3, O1);
                if (kc == c) {
                    const float ltot = xhalf_sum(lsum);
                    const float inv = 1.f / ltot;
                    const int bh = 2 * pr + pi, b = bh / BH, hd = bh % BH;
                    LAS unsigned char* tw = otl + r * 144 + 8 * hh;
#pragma unroll
                    for (int gq = 0; gq < 4; ++gq) {
                        u32x2 w0; w0.x = pk_bf16(O0[4 * gq] * inv, O0[4 * gq + 1] * inv); w0.y = pk_bf16(O0[4 * gq + 2] * inv, O0[4 * gq + 3] * inv);
                        u32x2 w1; w1.x = pk_bf16(O1[4 * gq] * inv, O1[4 * gq + 1] * inv); w1.y = pk_bf16(O1[4 * gq + 2] * inv, O1[4 * gq + 3] * inv);
                        *(LAS u32x2*)(tw + 16 * gq) = w0; *(LAS u32x2*)(tw + 64 + 16 * gq) = w1;
                    }
                    asm volatile("s_waitcnt lgkmcnt(0)" ::: "memory");
                    bf16* op = ao + ((size_t)b * SEQ + (size_t)c * CH + 32 * half + (lane >> 3)) * D + hd * DHD + 8 * (lane & 7);
                    const LAS unsigned char* tr = otl + (lane >> 3) * 144 + (lane & 7) * 16;
#pragma unroll
                    for (int k8 = 0; k8 < 4; ++k8) { const u32x4 ov = *(const LAS u32x4*)(tr + k8 * 8 * 144); *(u32x4*)(op + (size_t)(8 * k8) * D) = ov; }
                    asm volatile("s_waitcnt lgkmcnt(0)" ::: "memory");
                }
            }
        }
        asm volatile("s_waitcnt vmcnt(0) lgkmcnt(0)" ::: "memory"); __builtin_amdgcn_s_barrier(); asm volatile("" ::: "memory");
    }
#undef AT_ISSUE
#undef AT_QDMA
}

constexpr int N_PHASES = 22;
#ifndef DUPMASK
#define DUPMASK 0
#endif
#define REP(bit) for (int rep_ = 0; rep_ < (((DUPMASK) & (bit)) ? 2 : 1); ++rep_)
#define REPBAR() do { if (rep_) xcd_barrier(bar); } while (0)
__global__ void __launch_bounds__(NWAVES * 64, 2) yoco_fwd(Args args) {
    extern __shared__ __attribute__((aligned(16))) unsigned char lds[];
    Frame F;
    F.lds = (LAS unsigned char*)lds;
    F.tid = threadIdx.x; F.lane = F.tid & 63; F.wave = __builtin_amdgcn_readfirstlane(F.tid >> 6);
    F.G = gridDim.x; F.bx = blockIdx.x;
    unsigned char* ws = args.ws;
    unsigned* ctl = (unsigned*)(ws + WS_CTL);
    for (int u = F.tid; u < (LDS_BYTES - LDSCTL_OFF) / 4; u += NWAVES * 64) ((LAS unsigned*)(F.lds + LDSCTL_OFF))[u] = 0u;
    __syncthreads();
    volatile LAS unsigned* MISC = (volatile LAS unsigned*)(F.lds + MISC_OFF);
    XcdBarrier bar = xcd_barrier_post(ctl + CW_BAR, MISC + 8);
    const int lo = args.ph_lo, hi = args.ph_hi;
#define IN(k) (lo <= (k) && (k) < hi)
#define SEAM(k) do { if (IN(k) && IN((k) + 1)) xcd_barrier(bar); } while (0)
    float* out = args.out;
    bf16* XN = (bf16*)(ws + WS_XN); bf16* H = (bf16*)(ws + WS_H);
    bf16* KB = (bf16*)out; bf16* VT = (bf16*)out + (size_t)M * D;
    bf16* BIG = (bf16*)(ws + WS_BIG); bf16* KVT = (bf16*)(ws + WS_KVT); float* GATES = (float*)(ws + WS_GATES);
    u64* SSQ = (u64*)(ws + WS_SSQ);
    LAS unsigned char* ring = F.lds;

    if (IN(0)) REP(1) { REPBAR(); p0_prologue(F, args); xconv_phase(F, args.in[I_X], H, SSQ);
        for (int e = F.bx * NWAVES * 64 + F.tid; e < 8 * M / 2; e += F.G * NWAVES * 64) ((u32x4*)(SSQ + M))[e] = (u32x4){0u, 0u, 0u, 0u}; }
    SEAM(0);

    for (int l = 0; l < 4; ++l) {
        const int p = 1 + 5 * l;
        const u64* ssq_in = SSQ + (size_t)(2 * l) * M; u64* ssq_mid = SSQ + (size_t)(2 * l + 1) * M; u64* ssq_out = SSQ + (size_t)(2 * l + 2) * M;
        if (IN(p)) REP(4) { REPBAR();
            const bf16* wn; int nn; bf16* on; int ldn, splitc; bf16* on2;
            const bf16* wsw; int msw; bf16* osw;
            if (l < 2) {
                unsigned char* wb = ws + WS_WA + (size_t)l * WA_STRIDE;
                gates_phase(F, H, ssq_in, (const bf16*)(wb + WA_G), args.in[I_ABG] + l * 16, GATES);
                wn = (const bf16*)(wb + WA_QKO); nn = 2048; on = BIG; ldn = 2048; splitc = 0; on2 = nullptr;
                wsw = (const bf16*)(wb + WA_KV); msw = 1024; osw = KVT;
            } else if (l == 2) {
                wn = (const bf16*)(ws + WS_WQK2); nn = 2048; on = BIG; ldn = 1024; splitc = 1024; on2 = KB;
                wsw = (const bf16*)(ws + WS_WV); msw = 1024; osw = VT;
            } else {
                wn = (const bf16*)(ws + WS_WQ3); nn = 1024; on = BIG; ldn = 1024; splitc = 0; on2 = nullptr;
                wsw = nullptr; msw = 0; osw = nullptr;
            }
            { pg8::Gemm g{H, wn, M, nn, D}; pg8::StaticOrder S; S.init(M, nn, F.G, F.bx);
              pg8::EpiBf16 E{on, ldn, splitc, on2, ssq_in};
              pg8::gemm_phase<pg8::EpiBf16, pg8::StaticOrder, true, true>(ring, g, S, E); }
            if (msw) { pg8::Gemm g{wsw, H, msw, M, D}; pg8::StaticOrder S; S.init(msw, M, F.G, F.bx);
              pg8::EpiBf16K E{osw, M, 0, nullptr, ssq_in};
              pg8::gemm_phase<pg8::EpiBf16K, pg8::StaticOrder, true, true>(ring, g, S, E); }
        }
        SEAM(p);
        if (IN(p + 1)) REP(l < 2 ? 8 : 16) { REPBAR();
            if (l < 2) mlstm_phase(F, BIG, KVT, GATES, args.in[I_AGH] + l * D, XN);
            else attn_phase(F, BIG, KB, VT, args.in[I_BREL] + (size_t)(l - 2) * BH * NREL, XN);
        }
        SEAM(p + 1);
        if (IN(p + 2)) {
            const bf16* wo = (l < 2) ? (const bf16*)(ws + WS_WA + (size_t)l * WA_STRIDE + WA_OUT) : (const bf16*)(ws + WS_WO + (size_t)(l - 2) * 2 * MiB);
            pg8::Gemm g{XN, wo, M, D, D}; pg8::StaticOrder S; S.init(M, D, F.G, F.bx);
            pg8::EpiRes E{H, ssq_mid};
            pg8::gemm_phase<pg8::EpiRes, pg8::StaticOrder, true, true>(ring, g, S, E);
        }
        SEAM(p + 2);
        if (IN(p + 3)) REP(64) { REPBAR();
            pg8::Gemm g{H, (const bf16*)(ws + WS_WF + (size_t)l * WF_STRIDE), M, 2 * FF, D}; pg8::StaticOrder S; S.init(M, 2 * FF, F.G, F.bx);
            pg8::EpiSwiglu E{BIG, FF, ssq_mid};
            pg8::gemm_phase<pg8::EpiSwiglu, pg8::StaticOrder, true, true>(ring, g, S, E);
        }
        SEAM(p + 3);
        if (IN(p + 4)) {
            pg8::Gemm g{BIG, (const bf16*)(ws + WS_WF + (size_t)l * WF_STRIDE + WF_D), M, D, FF}; pg8::StaticOrder S; S.init(M, D, F.G, F.bx);
            pg8::EpiRes E{H, ssq_out};
            pg8::gemm_phase<pg8::EpiRes, pg8::StaticOrder, true, true>(ring, g, S, E);
        }
        SEAM(p + 4);
    }
    if (IN(21)) REP(128) { REPBAR(); final_norm_phase(F, H, SSQ + (size_t)8 * M, args.in[I_FING], out); }
#undef IN
#undef SEAM
}

extern "C" void kernel_launch(void* const* d_in, const int* in_sizes, int n_in, void* d_out, int out_size, void* d_ws, size_t ws_size, hipStream_t stream) {
    static int grid = 0;
    if (grid == 0) {
        if (n_in != 16 || out_size != M * D || ws_size < WS_END) { fprintf(stderr, "kernel_launch: unexpected shapes (n_in %d, out %d, ws %zu < %zu)\n", n_in, out_size, ws_size, (size_t)WS_END); }
        int dev = 0, cus = 0, per_cu = 0;
        hipGetDevice(&dev); hipDeviceGetAttribute(&cus, hipDeviceAttributeMultiprocessorCount, dev);
        hipFuncSetAttribute((const void*)yoco_fwd, hipFuncAttributeMaxDynamicSharedMemorySize, LDS_BYTES);
        hipOccupancyMaxActiveBlocksPerMultiprocessor(&per_cu, (const void*)yoco_fwd, NWAVES * 64, LDS_BYTES);
        (void)hipGetLastError();
        grid = cus > 0 ? cus : 256;
        if (per_cu < 1) fprintf(stderr, "kernel_launch: occupancy query says %d\n", per_cu);
    }
    hipMemsetAsync((char*)d_ws + WS_CTL, 0, CTL_ZERO_BYTES, stream);
    Args a{};
    for (int i = 0; i < 16; ++i) a.in[i] = (const float*)d_in[i];
    a.out = (float*)d_out; a.ws = (unsigned char*)d_ws;
#if MK_N_LAUNCHES == 1
    a.ph_lo = 0; a.ph_hi = N_PHASES;
    hipLaunchKernelGGL(yoco_fwd, dim3(grid), dim3(NWAVES * 64), LDS_BYTES, stream, a);
#else
    for (int p = 0; p < N_PHASES; ++p) { a.ph_lo = p; a.ph_hi = p + 1; hipLaunchKernelGGL(yoco_fwd, dim3(grid), dim3(NWAVES * 64), LDS_BYTES, stream, a); }
#endif
}
```

```cpp
#include <hip/hip_runtime.h>
#include <cstdio>
#include <cstdint>

#ifndef MK_N_LAUNCHES
#define MK_N_LAUNCHES 1
#endif

#define GAS __attribute__((address_space(1)))
#define LAS __attribute__((address_space(3)))
typedef unsigned short bf16;
typedef short bf16x8 __attribute__((ext_vector_type(8)));
typedef float f32x2 __attribute__((ext_vector_type(2)));
typedef float f32x4 __attribute__((ext_vector_type(4)));
typedef float f32x16 __attribute__((ext_vector_type(16)));
typedef unsigned u32x2 __attribute__((ext_vector_type(2)));
typedef unsigned u32x4 __attribute__((ext_vector_type(4)));
typedef __bf16 bf16x2_t __attribute__((ext_vector_type(2)));

constexpr int M = 65536, D = 1024, SEQ = 2048, NBATCH = 32, CH = 64, NCH = 32;
constexpr int AH = 8, DQK = 64, DV = 128, AIN = 3088;
constexpr int BH = 16, DHD = 64, FF = 2816, NREL = 513;
constexpr float EPS = 1e-6f;
constexpr float LOG2E = 1.4426950408889634f;
typedef unsigned long long u64;
constexpr float SSQ_FIX = 1048576.0f;
__device__ __forceinline__ float u64f(u64 q) { return __builtin_fmaf((float)(unsigned)(q >> 32), 4294967296.0f, (float)(unsigned)q); }
__device__ __forceinline__ float rstd_of(u64 q) { return __builtin_amdgcn_rsqf(u64f(q) * (1.0f / (1048576.0f * 1024.0f)) + 1e-6f); }

__device__ __forceinline__ unsigned pk_bf16(float lo, float hi) { f32x2 v = {lo, hi}; bf16x2_t b = __builtin_convertvector(v, bf16x2_t); return __builtin_bit_cast(unsigned, b); }
__device__ __forceinline__ float bf_lo(unsigned u) { return __uint_as_float(u << 16); }
__device__ __forceinline__ float bf_hi(unsigned u) { return __uint_as_float(u & 0xffff0000u); }
__device__ __forceinline__ float fast_exp2(float x) { return __builtin_amdgcn_exp2f(x); }
__device__ __forceinline__ float fast_exp(float x) { return __builtin_amdgcn_exp2f(x * LOG2E); }
__device__ __forceinline__ float fast_rcp(float x) { return __builtin_amdgcn_rcpf(x); }

namespace pg8 {
#define PG8_LAS __attribute__((address_space(3)))
typedef unsigned short bf16_t;
constexpr int BM = 256, BK = 64, HALF = 128, HTB = HALF * BK * 2, STAGE_BYTES = 8 * HTB, NXCD = 8, WGM = 8;
constexpr int EPI_T_OFF = STAGE_BYTES + 6144, EPI_T_WAVE = 16 * 144;
constexpr int SIDE_OFF = STAGE_BYTES + 1024, SIDE_BYTES = 2048;

__host__ __device__ __forceinline__ int lds_byte(int r, int c) { const int st = (r >> 4) * 2 + (c >> 5), rr = r & 15, cc = c & 31, ob = rr * 64 + cc * 2; return st * 1024 + (ob ^ (((ob >> 9) & 1) << 5)); }
__host__ __device__ __forceinline__ void stage_rc(int b, int& R, int& C) { const int st = b / 1024, sb = b % 1024, swz = sb ^ (((sb >> 9) & 1) << 5); R = (st >> 1) * 16 + swz / 64; C = (st & 1) * 32 + (swz % 64) / 2; }
__host__ __device__ __forceinline__ int perm32(int rho) { const int n = rho >> 4, i = rho & 15; return 8 * (i >> 2) + 4 * n + (i & 3); }
__host__ __device__ __forceinline__ int perm32k(int rho) { const int n = rho >> 4, i = rho & 15, fq = i >> 2, e = i & 3; return 16 * (fq >> 1) + 4 * (fq & 1) + 8 * n + e; }

struct Unit { int pm, pn; };
struct Gemm { const bf16_t* A; const bf16_t* Bt; int M, N, K; };

struct StaticOrder {
    int nM, nN, nwg, G, c;
    __host__ __device__ void init(int M_, int N_, int G_, int c_) { nM = M_ / BM; nN = N_ / BM; nwg = nM * nN; G = G_; c = c_; }
    __host__ __device__ bool next(int i, Unit& u) const {
        const long L = (long)i * G + c; if (L >= nwg) return false;
        int wgid = (int)L; { const int q = nwg / NXCD, r = nwg % NXCD, xcd = wgid % NXCD, off = wgid / NXCD; wgid = (xcd < r ? xcd * (q + 1) : r * (q + 1) + (xcd - r) * q) + off; }
        const int nig = WGM * nN, gid = wgid / nig, fm = gid * WGM, gsz = (nM - fm) < WGM ? (nM - fm) : WGM;
        u.pm = fm + ((wgid % nig) % gsz); u.pn = (wgid % nig) / gsz; return true;
    }
    __device__ __forceinline__ void a_ready(const Unit&) const {}
    __device__ __forceinline__ void done(const Unit&) const {}
};

template <int NM_, int NN_> struct StaticOrderC {
    int G, c;
    __host__ __device__ void init(int, int, int G_, int c_) { G = G_; c = c_; }
    __host__ __device__ bool next(int i, Unit& u) const {
        constexpr int nM = NM_, nN = NN_, nwg = nM * nN, q = nwg / NXCD, r = nwg % NXCD, nig = WGM * nN;
        const long L = (long)i * G + c; if (L >= nwg) return false;
        int wgid = (int)L; { const int xcd = wgid % NXCD, off = wgid / NXCD; wgid = (xcd < r ? xcd * (q + 1) : r * (q + 1) + (xcd - r) * q) + off; }
        const int gid = wgid / nig, fm = gid * WGM;
        if constexpr (nM % WGM == 0) { u.pm = fm + ((wgid % nig) % WGM); u.pn = (wgid % nig) / WGM; }
        else { const int gsz = (nM - fm) < WGM ? (nM - fm) : WGM; u.pm = fm + ((wgid % nig) % gsz); u.pn = (wgid % nig) / gsz; }
        return true;
    }
    __device__ __forceinline__ void a_ready(const Unit&) const {}
    __device__ __forceinline__ void done(const Unit&) const {}
};

template <bool KPERM> struct EpiBf16T {
    static constexpr bool PERM = true, AFTER_DRAIN = false, WIDE = true;
    static __host__ __device__ __forceinline__ int permf(int rho) { return KPERM ? perm32k(rho) : perm32(rho); }
    bf16_t* O; int ldc; int split_cols; bf16_t* O2; const u64* ssq;
    __device__ __forceinline__ void prestage(PG8_LAS unsigned char* lds, const Unit& u, int par, int wid, int lane) const {
        if (wid < 2) { const int t0 = (KPERM ? u.pn : u.pm) * BM + 128 * wid;
            __builtin_amdgcn_global_load_lds((const unsigned*)(ssq + t0 + 2 * lane), (PG8_LAS unsigned*)(lds + SIDE_OFF + par * SIDE_BYTES + wid * 1024), 16, 0, 0); }
    }
    __device__ __forceinline__ void operator()(f32x4 (&acc)[2][2][4][2], const Unit& u, int wr, int wc, int fr, int fq, const PG8_LAS unsigned char* side, PG8_LAS unsigned char* tl, int lane) const {
        int colt = u.pn * BM; bf16_t* base = O;
        if (split_cols && colt >= split_cols) { base = O2; colt -= split_cols; }
        const PG8_LAS u64* sq = (const PG8_LAS u64*)side;
        float rs[2][4]; f32x4 cs[2][2];
        if constexpr (!KPERM) {
#pragma unroll
            for (int ai = 0; ai < 2; ++ai)
#pragma unroll
                for (int m = 0; m < 4; ++m) rs[ai][m] = rstd_of(sq[wr * 64 + fr + ai * HALF + m * 16]);
        } else {
            const int tok0 = wc * 64 + 16 * (fq >> 1) + 4 * (fq & 1);
#pragma unroll
            for (int bj = 0; bj < 2; ++bj)
#pragma unroll
                for (int n = 0; n < 2; ++n) {
#pragma unroll
                    for (int e = 0; e < 4; ++e) cs[bj][n][e] = rstd_of(sq[tok0 + bj * 32 + 8 * n + e]); }
        }
        PG8_LAS unsigned char* wp = tl + fr * 144 + fq * 16;
        const PG8_LAS unsigned char* rp = tl + (lane >> 3) * 144 + (lane & 7) * 16;
        bf16_t* gp = base + (size_t)(u.pm * BM + wr * 64 + (lane >> 3)) * ldc + colt + wc * 64 + 8 * (lane & 7);
#pragma unroll
        for (int ai = 0; ai < 2; ++ai)
#pragma unroll
            for (int m = 0; m < 4; ++m) {
#pragma unroll
                for (int bj = 0; bj < 2; ++bj) { f32x4 v0 = acc[ai][bj][m][0], v1 = acc[ai][bj][m][1]; acc[ai][bj][m][0] = (f32x4){0.f, 0.f, 0.f, 0.f}; acc[ai][bj][m][1] = (f32x4){0.f, 0.f, 0.f, 0.f};
                    if constexpr (!KPERM) { v0 = v0 * rs[ai][m]; v1 = v1 * rs[ai][m]; } else { v0 = v0 * cs[bj][0]; v1 = v1 * cs[bj][1]; }
                    u32x4 w; w.x = pk_bf16(v0[0], v0[1]); w.y = pk_bf16(v0[2], v0[3]); w.z = pk_bf16(v1[0], v1[1]); w.w = pk_bf16(v1[2], v1[3]);
                    *(PG8_LAS u32x4*)(wp + bj * 64) = w; }
                asm volatile("" ::: "memory");
                const u32x4 o0 = *(const PG8_LAS u32x4*)rp, o1 = *(const PG8_LAS u32x4*)(rp + 8 * 144);
                asm volatile("" ::: "memory");
                bf16_t* g0 = gp + (size_t)(ai * HALF + m * 16) * ldc;
                __builtin_nontemporal_store(o0, (u32x4*)g0); __builtin_nontemporal_store(o1, (u32x4*)(g0 + (size_t)8 * ldc));
            }
    }
};
typedef EpiBf16T<false> EpiBf16;
typedef EpiBf16T<true> EpiBf16K;
struct EpiSwiglu {
    static constexpr bool PERM = true, AFTER_DRAIN = false, WIDE = false;
    static __host__ __device__ __forceinline__ int permf(int rho) { return perm32(rho); }
    bf16_t* O; int ldc; const u64* ssq;
    __device__ __forceinline__ void prestage(PG8_LAS unsigned char* lds, const Unit& u, int par, int wid, int lane) const {
        if (wid < 2) { const int t0 = u.pm * BM + 128 * wid;
            __builtin_amdgcn_global_load_lds((const unsigned*)(ssq + t0 + 2 * lane), (PG8_LAS unsigned*)(lds + SIDE_OFF + par * SIDE_BYTES + wid * 1024), 16, 0, 0); }
    }
    __device__ __forceinline__ void operator()(f32x4 (&acc)[2][2][4][2], const Unit& u, int wr, int wc, int fr, int fq, const PG8_LAS unsigned char* side, PG8_LAS unsigned char*, int) const {
        const int row0 = u.pm * BM + wr * 64 + fr; const int col0 = u.pn * HALF + wc * 32 + 8 * fq;
        const PG8_LAS u64* sq = (const PG8_LAS u64*)side;
#pragma unroll
        for (int ai = 0; ai < 2; ++ai)
#pragma unroll
            for (int m = 0; m < 4; ++m) { const int row = row0 + ai * HALF + m * 16; bf16_t* rowp = O + (size_t)row * ldc + col0;
                const float ms = u64f(sq[wr * 64 + fr + ai * HALF + m * 16]) * (1.0f / (1048576.0f * 1024.0f)) + 1e-6f;
                const float nrs = -__builtin_amdgcn_rsqf(ms) * LOG2E;
                float o[8];
#pragma unroll
                for (int n = 0; n < 2; ++n)
#pragma unroll
                    for (int e = 0; e < 4; ++e) { const float ag = acc[ai][0][m][n][e], au = acc[ai][1][m][n][e];
                        o[4 * n + e] = (ag * au) * fast_rcp(__builtin_fmaf(fast_exp2(ag * nrs), ms, ms)); }
#pragma unroll
                for (int n = 0; n < 2; ++n) { acc[ai][0][m][n] = (f32x4){0.f, 0.f, 0.f, 0.f}; acc[ai][1][m][n] = (f32x4){0.f, 0.f, 0.f, 0.f}; }
                u32x4 w; w.x = pk_bf16(o[0], o[1]); w.y = pk_bf16(o[2], o[3]); w.z = pk_bf16(o[4], o[5]); w.w = pk_bf16(o[6], o[7]);
                __builtin_nontemporal_store(w, (u32x4*)rowp); }
    }
};
struct EpiRes {
    static constexpr bool PERM = true, AFTER_DRAIN = false, WIDE = true;
    static __host__ __device__ __forceinline__ int permf(int rho) { return perm32(rho); }
    bf16_t* H; u64* ssq_out;
    __device__ __forceinline__ void prestage(PG8_LAS unsigned char*, const Unit&, int, int, int) const {}
    __device__ __forceinline__ void operator()(f32x4 (&acc)[2][2][4][2], const Unit& u, int wr, int wc, int fr, int fq, const PG8_LAS unsigned char*, PG8_LAS unsigned char* tl, int lane) const {
        const int row0 = u.pm * BM + wr * 64 + fr, col0 = u.pn * BM + wc * 64 + 8 * fq;
        PG8_LAS unsigned char* ap = tl + fr * 144 + fq * 16;
        const PG8_LAS unsigned char* rp = tl + (lane >> 3) * 144 + (lane & 7) * 16;
        bf16_t* gp = H + (size_t)(u.pm * BM + wr * 64 + (lane >> 3)) * D + u.pn * BM + wc * 64 + 8 * (lane & 7);
#pragma unroll
        for (int ai = 0; ai < 2; ++ai) {
            u32x4 hv8[4][2];
#pragma unroll
            for (int m = 0; m < 4; ++m)
#pragma unroll
                for (int bj = 0; bj < 2; ++bj) hv8[m][bj] = *(const u32x4*)(H + (size_t)(row0 + ai * HALF + m * 16) * D + col0 + bj * 32);
#pragma unroll
            for (int m = 0; m < 4; ++m) { const int row = row0 + ai * HALF + m * 16; float part = 0.f;
#pragma unroll
                for (int bj = 0; bj < 2; ++bj) { const u32x4 hv = hv8[m][bj];
                    const f32x4 a0 = acc[ai][bj][m][0], a1 = acc[ai][bj][m][1]; acc[ai][bj][m][0] = (f32x4){0.f, 0.f, 0.f, 0.f}; acc[ai][bj][m][1] = (f32x4){0.f, 0.f, 0.f, 0.f};
                    const float y0 = a0[0] + bf_lo(hv.x), y1 = a0[1] + bf_hi(hv.x), y2 = a0[2] + bf_lo(hv.y), y3 = a0[3] + bf_hi(hv.y);
                    const float y4 = a1[0] + bf_lo(hv.z), y5 = a1[1] + bf_hi(hv.z), y6 = a1[2] + bf_lo(hv.w), y7 = a1[3] + bf_hi(hv.w);
                    part += ((y0 * y0 + y1 * y1) + (y2 * y2 + y3 * y3)) + ((y4 * y4 + y5 * y5) + (y6 * y6 + y7 * y7));
                    u32x4 w; w.x = pk_bf16(y0, y1); w.y = pk_bf16(y2, y3); w.z = pk_bf16(y4, y5); w.w = pk_bf16(y6, y7);
                    *(PG8_LAS u32x4*)(ap + bj * 64) = w; }
                asm volatile("" ::: "memory");
                const u32x4 o0 = *(const PG8_LAS u32x4*)rp, o1 = *(const PG8_LAS u32x4*)(rp + 8 * 144);
                asm volatile("" ::: "memory");
                bf16_t* g0 = gp + (size_t)(ai * HALF + m * 16) * D;
                *(u32x4*)g0 = o0; *(u32x4*)(g0 + (size_t)8 * D) = o1;
                { const auto r16 = __builtin_amdgcn_permlane16_swap(__float_as_uint(part), __float_as_uint(part), false, false); part = __uint_as_float(r16[0]) + __uint_as_float(r16[1]); }
                { const auto r32 = __builtin_amdgcn_permlane32_swap(__float_as_uint(part), __float_as_uint(part), false, false); part = __uint_as_float(r32[0]) + __uint_as_float(r32[1]); }
                if (fq == 0) atomicAdd(ssq_out + row, (u64)(part * SSQ_FIX)); }
        }
    }
};

template <class Epi, class Sched, bool ALIGN_EPI = false, bool SP2 = false>
__device__ __forceinline__ void gemm_phase(PG8_LAS unsigned char* lds, const Gemm g, const Sched& S, const Epi& E) {
    int tid_ = threadIdx.x; asm volatile("" : "+v"(tid_));
    const int tid = tid_, wid = __builtin_amdgcn_readfirstlane(tid >> 6), lane = tid & 63, wr = wid >> 2, wc = wid & 3, fr = lane & 15, fq = lane >> 4;
    const int K = g.K, nt = K / BK;
    unsigned voffA[2], voffB[2];
#pragma unroll
    for (int i = 0; i < 2; ++i) { int R, C; stage_rc(tid * 16 + i * 8192, R, C); const int Rb = Epi::WIDE ? (64 * (R >> 5) + Epi::permf(R & 31)) : (Epi::PERM ? ((R & ~31) + Epi::permf(R & 31)) : R);
        voffA[i] = (unsigned)(R * K + C) * 2u; voffB[i] = (unsigned)(Rb * K + C) * 2u; }
    const size_t kstep = (size_t)(BK * 2);
    const size_t hstep = (size_t)HALF * K * 2;
    const size_t hstepB = Epi::WIDE ? (size_t)32 * K * 2 : hstep;
    const size_t tstep = 2 * hstep;
    const unsigned ldsw = (unsigned)wid * 1024u;
    const int aoff = lds_byte(wr * 64 + fr, fq * 8), boff = lds_byte(wc * 32 + fr, fq * 8);
#define PG8_SA(b, h) (((b) * 2 + (h)) * HTB)
#define PG8_SB(b, h) ((4 + (b) * 2 + (h)) * HTB)
#define PG8_STAGE(bufoff, gbase, voff) do { _Pragma("unroll") for (int _i = 0; _i < 2; ++_i) \
        __builtin_amdgcn_global_load_lds((const unsigned*)((const char*)(gbase) + (voff)[_i]), (PG8_LAS unsigned*)(lds + (bufoff) + ldsw + _i * 8192), 16, 0, 0); } while (0)
#define PG8_LDA(dst, b, h) do { _Pragma("unroll") for (int m = 0; m < 4; ++m) _Pragma("unroll") for (int k = 0; k < 2; ++k) dst[m][k] = *(const PG8_LAS bf16x8*)(lds + PG8_SA(b, h) + aoff + m * 2048 + k * 1024); } while (0)
#define PG8_LDB(dst, b, h) do { _Pragma("unroll") for (int n = 0; n < 2; ++n) _Pragma("unroll") for (int k = 0; k < 2; ++k) dst[n][k] = *(const PG8_LAS bf16x8*)(lds + PG8_SB(b, h) + boff + n * 2048 + k * 1024); } while (0)
#define PG8_MMA(ai, bj, At, Bt) do { __builtin_amdgcn_s_setprio(1); _Pragma("unroll") for (int m = 0; m < 4; ++m) _Pragma("unroll") for (int n = 0; n < 2; ++n) _Pragma("unroll") for (int k = 0; k < 2; ++k) \
        acc[ai][bj][m][n] = __builtin_amdgcn_mfma_f32_16x16x32_bf16(Bt[n][k], At[m][k], acc[ai][bj][m][n], 0, 0, 0); __builtin_amdgcn_s_setprio(0); } while (0)
#define PG8_WAIT_V(n) asm volatile("s_waitcnt vmcnt(" #n ")" ::: "memory")
#define PG8_WAIT_L(n) asm volatile("s_waitcnt lgkmcnt(" #n ")" ::: "memory")
#define PG8_BAR __builtin_amdgcn_s_barrier()
#define PG8_SCHED __builtin_amdgcn_sched_barrier(0)
    Unit cur, nxt; int ui = 0;
    if (!S.next(0, cur)) return;
    f32x4 acc[2][2][4][2];
#pragma unroll
    for (int a = 0; a < 2; ++a)
#pragma unroll
        for (int b = 0; b < 2; ++b)
#pragma unroll
            for (int m = 0; m < 4; ++m)
#pragma unroll
                for (int n = 0; n < 2; ++n) acc[a][b][m][n] = (f32x4){0.f, 0.f, 0.f, 0.f};
    bf16x8 At[4][2], B0[2][2], B1[2][2];
    const char* cA = (const char*)g.A + (size_t)cur.pm * tstep; const char* cB = (const char*)g.Bt + (size_t)cur.pn * tstep;
    S.a_ready(cur);
    if constexpr (SP2) {
        PG8_STAGE(PG8_SB(0, 0), cB, voffB); PG8_STAGE(PG8_SB(0, 1), cB + hstepB, voffB); PG8_STAGE(PG8_SA(0, 0), cA, voffA); PG8_STAGE(PG8_SA(0, 1), cA + hstep, voffA);
        if (wr == 1) PG8_BAR;
        PG8_WAIT_V(2); PG8_BAR;
        PG8_STAGE(PG8_SB(1, 0), cB + kstep, voffB); PG8_STAGE(PG8_SA(1, 0), cA + kstep, voffA); PG8_STAGE(PG8_SB(1, 1), cB + hstepB + kstep, voffB);
        PG8_WAIT_V(6); PG8_BAR;
    } else {
        PG8_STAGE(PG8_SB(0, 0), cB, voffB); PG8_STAGE(PG8_SA(0, 0), cA, voffA); PG8_STAGE(PG8_SB(0, 1), cB + hstepB, voffB); PG8_STAGE(PG8_SA(0, 1), cA + hstep, voffA);
        if (wr == 1) PG8_BAR;
        PG8_WAIT_V(4); PG8_BAR;
        PG8_STAGE(PG8_SB(1, 0), cB + kstep, voffB); PG8_STAGE(PG8_SA(1, 0), cA + kstep, voffA); PG8_STAGE(PG8_SB(1, 1), cB + hstepB + kstep, voffB);
        PG8_WAIT_V(6); PG8_BAR;
    }
    for (;;) {
        const bool has_next = S.next(ui + 1, nxt);
        const char* nA = has_next ? (const char*)g.A + (size_t)nxt.pm * tstep : cA; const char* nB = has_next ? (const char*)g.Bt + (size_t)nxt.pn * tstep : cB;
        E.prestage(lds, cur, ui & 1, wid, lane);
        for (int t = 0; t < nt; t += 2) {
            const bool last = (t == nt - 2);
            const char* a1 = cA + (size_t)(t + 1) * kstep;
            const char* a2 = last ? nA : cA + (size_t)(t + 2) * kstep; const char* b2 = last ? nB : cB + (size_t)(t + 2) * kstep;
            const char* a3 = a2 + kstep; const char* b3 = b2 + kstep;
            if (last && has_next) S.a_ready(nxt);
            if constexpr (SP2) {
            PG8_LDB(B0, 0, 0); PG8_LDB(B1, 0, 1); PG8_SCHED; PG8_LDA(At, 0, 0); PG8_STAGE(PG8_SA(1, 1), a1 + hstep, voffA);
            PG8_WAIT_V(8); PG8_WAIT_L(0); PG8_BAR; PG8_MMA(0, 0, At, B0); PG8_MMA(0, 1, At, B1); PG8_BAR; PG8_SCHED;
            PG8_LDA(At, 0, 1); PG8_STAGE(PG8_SB(0, 0), b2, voffB); PG8_STAGE(PG8_SB(0, 1), b2 + hstepB, voffB); PG8_STAGE(PG8_SA(0, 0), a2, voffA);
            PG8_WAIT_V(8); PG8_WAIT_L(0); PG8_BAR; PG8_MMA(1, 0, At, B0); PG8_MMA(1, 1, At, B1); PG8_BAR; PG8_SCHED;
            PG8_LDB(B0, 1, 0); PG8_LDB(B1, 1, 1); PG8_SCHED; PG8_LDA(At, 1, 0); PG8_STAGE(PG8_SA(0, 1), a2 + hstep, voffA);
            PG8_WAIT_V(8); PG8_WAIT_L(0); PG8_BAR; PG8_MMA(0, 0, At, B0); PG8_MMA(0, 1, At, B1); PG8_BAR; PG8_SCHED;
            PG8_LDA(At, 1, 1); PG8_STAGE(PG8_SB(1, 0), b3, voffB); PG8_STAGE(PG8_SB(1, 1), b3 + hstepB, voffB); PG8_STAGE(PG8_SA(1, 0), a3, voffA);
            PG8_WAIT_V(8); PG8_WAIT_L(0); PG8_BAR; PG8_MMA(1, 0, At, B0); PG8_MMA(1, 1, At, B1); PG8_BAR; PG8_SCHED;
            } else {
            PG8_LDB(B0, 0, 0); PG8_SCHED; PG8_LDA(At, 0, 0); PG8_STAGE(PG8_SA(1, 1), a1 + hstep, voffA);
            PG8_WAIT_L(8); PG8_BAR; PG8_WAIT_L(0); PG8_MMA(0, 0, At, B0); PG8_BAR; PG8_SCHED;
            PG8_LDB(B1, 0, 1); PG8_STAGE(PG8_SB(0, 0), b2, voffB);
            PG8_BAR; PG8_WAIT_L(0); PG8_MMA(0, 1, At, B1); PG8_BAR;
            PG8_LDA(At, 0, 1); PG8_STAGE(PG8_SA(0, 0), a2, voffA);
            PG8_BAR; PG8_WAIT_L(0); PG8_MMA(1, 0, At, B0); PG8_BAR; PG8_SCHED;
            PG8_STAGE(PG8_SB(0, 1), b2 + hstepB, voffB);
            PG8_WAIT_V(6); PG8_BAR; PG8_MMA(1, 1, At, B1); PG8_BAR;
            PG8_LDB(B0, 1, 0); PG8_SCHED; PG8_LDA(At, 1, 0); PG8_STAGE(PG8_SA(0, 1), a2 + hstep, voffA);
            PG8_WAIT_L(8); PG8_BAR; PG8_WAIT_L(0); PG8_MMA(0, 0, At, B0); PG8_BAR; PG8_SCHED;
            PG8_LDB(B1, 1, 1); PG8_STAGE(PG8_SB(1, 0), b3, voffB);
            PG8_BAR; PG8_WAIT_L(0); PG8_MMA(0, 1, At, B1); PG8_BAR;
            PG8_LDA(At, 1, 1); PG8_STAGE(PG8_SA(1, 0), a3, voffA);
            PG8_BAR; PG8_WAIT_L(0); PG8_MMA(1, 0, At, B0); PG8_BAR; PG8_SCHED;
            PG8_STAGE(PG8_SB(1, 1), b3 + hstepB, voffB);
            PG8_WAIT_V(6); PG8_BAR; PG8_MMA(1, 1, At, B1); PG8_BAR;
            }
        }
        if constexpr (ALIGN_EPI) { if (wr == 0) PG8_BAR; }
        if constexpr (!Epi::AFTER_DRAIN) { E(acc, cur, wr, wc, fr, fq, lds + SIDE_OFF + (ui & 1) * SIDE_BYTES, lds + EPI_T_OFF + wid * EPI_T_WAVE, lane); S.done(cur); }
        if (!has_next) break;
        cur = nxt; cA = nA; cB = nB; ++ui;
        if constexpr (ALIGN_EPI) { if (wr == 1) PG8_BAR; }
    }
    PG8_WAIT_V(0);
    if constexpr (!ALIGN_EPI) { if (wr == 0) PG8_BAR; }
    PG8_BAR;
#undef PG8_SA
#undef PG8_SB
#undef PG8_STAGE
#undef PG8_LDA
#undef PG8_LDB
#undef PG8_MMA
#undef PG8_WAIT_V
#undef PG8_WAIT_L
#undef PG8_BAR
#undef PG8_SCHED
}
}

constexpr size_t MiB = 1u << 20;
constexpr size_t WS_CTL = 0, CTL_ZERO_BYTES = 6 * MiB;
constexpr size_t WS_SSQ = 1 * MiB, SSQ_STRIDE = (size_t)M * 8;
constexpr size_t WS_WA = 6 * MiB;
constexpr size_t WA_STRIDE = 10 * MiB, WA_QKO = 0, WA_KV = 4 * MiB, WA_G = 7 * MiB, WA_OUT = 8 * MiB;
constexpr size_t WS_WQK2 = 26 * MiB;
constexpr size_t WS_WQ3 = 30 * MiB;
constexpr size_t WS_WV = 32 * MiB;
constexpr size_t WS_WO = 34 * MiB;
constexpr size_t WS_WF = 38 * MiB;
constexpr size_t WF_STRIDE = 17 * MiB, WF_D = 11 * MiB;
constexpr size_t WS_GATES = 106 * MiB;
constexpr size_t WS_XN = 110 * MiB;
constexpr size_t WS_H = 238 * MiB;
constexpr size_t WS_BIG = 366 * MiB;
constexpr size_t WS_KVT = WS_BIG + 256 * MiB;
constexpr size_t WS_END = WS_KVT + 192 * MiB;
static_assert(WS_SSQ + 9 * SSQ_STRIDE <= CTL_ZERO_BYTES && WS_WF + 4 * WF_STRIDE <= WS_GATES && WS_GATES + (size_t)M * 16 * 4 <= WS_XN && WS_XN + (size_t)M * D * 2 <= WS_H && WS_H + (size_t)M * D * 2 <= WS_BIG, "ws map");
static_assert(WS_BIG + (size_t)M * FF * 2 <= WS_END, "ws map");

constexpr int CW_BAR = 4096;
constexpr int RING_BYTES = 131072;
constexpr int LDSCTL_OFF = 163840 - 1024, MISC_OFF = LDSCTL_OFF + 320;
constexpr int LDS_BYTES = 163840;
constexpr int NWAVES = 8;

#define XB_TMO      128
#define XB_XCNT(j)  (256  + 64 * (j))
#define XB_XSUB(j)  (1280 + 64 * (j))
#define XB_XGEN(j)  (2304 + 64 * (j))
#define XB_TOP      3328
#define XB_TOPGEN   3392
#define XCD_BAR_WORDS 3456
#define XB_SPIN_CAP (1u << 18)

__device__ __forceinline__ unsigned xb_ld(unsigned* p)              { return __hip_atomic_load(p, __ATOMIC_RELAXED, __HIP_MEMORY_SCOPE_AGENT); }
__device__ __forceinline__ unsigned xb_add(unsigned* p, unsigned v) { return __hip_atomic_fetch_add(p, v, __ATOMIC_RELAXED, __HIP_MEMORY_SCOPE_AGENT); }
__device__ __forceinline__ unsigned xb_xcc_id() { return (unsigned)__builtin_amdgcn_s_getreg((3 << 11) | 20) & 0xFu; }
#define XB_SPIN(cond, bar) do { unsigned _sp = 0; while (cond) { __builtin_amdgcn_s_sleep(1); \
    if ((++_sp & 255u) == 0u) { if (xb_ld(&(bar)[XB_TMO])) break; if (_sp > XB_SPIN_CAP) { atomicAdd(&(bar)[XB_TMO], 1u); break; } } } } while (0)

struct XcdBarrier { unsigned* bar; unsigned x; volatile LAS unsigned* st; };

__device__ __forceinline__ XcdBarrier xcd_barrier_post(unsigned* bar, volatile LAS unsigned* st) {
    XcdBarrier b; b.bar = bar; b.x = xb_xcc_id(); b.st = st;
    if (threadIdx.x == 0) (void)xb_add(&bar[XB_XCNT(b.x)], 1u);
    return b;
}
__device__ __forceinline__ void xcd_barrier_complete(unsigned* bar, unsigned x, unsigned& nloc, unsigned& nx) {
    const unsigned G = gridDim.x * gridDim.y * gridDim.z;
    unsigned sum, cnt, mine, sp = 0u;
    for (;;) {
        sum = 0u; cnt = 0u; mine = 0u;
#pragma unroll
        for (unsigned j = 0; j < 16; ++j) { const unsigned c = xb_ld(&bar[XB_XCNT(j)]); sum += c; cnt += (c > 0u) ? 1u : 0u; mine = (j == x) ? c : mine; }
        if (sum == G) break;
        __builtin_amdgcn_s_sleep(1);
        if ((++sp & 255u) == 0u) { if (xb_ld(&bar[XB_TMO])) break; if (sp > XB_SPIN_CAP) { atomicAdd(&bar[XB_TMO], 1u); break; } }
    }
    nloc = mine > 0u ? mine : 1u; nx = cnt > 0u ? cnt : 1u;
}
__device__ __forceinline__ void xcd_barrier(const XcdBarrier& b) {
    asm volatile("s_waitcnt vmcnt(0)" ::: "memory");
    __syncthreads();
    if (threadIdx.x == 0) {
        unsigned* bar = b.bar;
        __builtin_amdgcn_s_waitcnt(0);
        unsigned nloc = b.st[0], nx = b.st[1];
        if (nloc == 0u) { xcd_barrier_complete(bar, b.x, nloc, nx); b.st[0] = nloc; b.st[1] = nx; }
        const unsigned old = xb_add(&bar[XB_XSUB(b.x)], 1u);
        const unsigned gen = old / nloc;
        if (old + 1u == (gen + 1u) * nloc) {
            __builtin_amdgcn_fence(__ATOMIC_RELEASE, "agent");
            asm volatile("s_waitcnt vmcnt(0)" ::: "memory");
            const unsigned og = xb_add(&bar[XB_TOP], 1u);
            const unsigned tg = og / nx;
            if (og + 1u == (tg + 1u) * nx) xb_add(&bar[XB_TOPGEN], 1u);
            else XB_SPIN(xb_ld(&bar[XB_TOPGEN]) == tg, bar);
            __builtin_amdgcn_fence(__ATOMIC_ACQUIRE, "agent");
            xb_add(&bar[XB_XGEN(b.x)], 1u);
            asm volatile("s_waitcnt vmcnt(0)" ::: "memory");
        } else {
            XB_SPIN(xb_ld(&bar[XB_XGEN(b.x)]) == gen, bar);
            __builtin_amdgcn_fence(__ATOMIC_ACQUIRE, "agent");
            asm volatile("s_waitcnt vmcnt(0)" ::: "memory");
        }
    }
    __syncthreads();
}

#define LDS_WAIT() asm volatile("s_waitcnt lgkmcnt(0)" ::: "memory")
__device__ __forceinline__ float wave_sum(float v) {
#pragma unroll
    for (int o = 1; o < 64; o <<= 1) v += __shfl_xor(v, o);
    return v;
}
__device__ __forceinline__ float xhalf_max(float x) { const auto r = __builtin_amdgcn_permlane32_swap(__float_as_uint(x), __float_as_uint(x), false, false); return fmaxf(__uint_as_float(r[0]), __uint_as_float(r[1])); }
__device__ __forceinline__ float xhalf_sum(float x) { const auto r = __builtin_amdgcn_permlane32_swap(__float_as_uint(x), __float_as_uint(x), false, false); return __uint_as_float(r[0]) + __uint_as_float(r[1]); }
__device__ __forceinline__ int crow(int reg, int hh) { return (reg & 3) + 8 * (reg >> 2) + 4 * hh; }
__device__ __forceinline__ f32x16 mfma32(bf16x8 a, bf16x8 b, f32x16 c) { return __builtin_amdgcn_mfma_f32_32x32x16_bf16(a, b, c, 0, 0, 0); }
__device__ __forceinline__ f32x16 zero16() { f32x16 z;
#pragma unroll
    for (int i = 0; i < 16; ++i) z[i] = 0.f;
    return z; }
__device__ __forceinline__ bf16x8 pack8(const f32x16& x, int s) {
    u32x4 p; p.x = pk_bf16(x[8 * s + 0], x[8 * s + 1]); p.y = pk_bf16(x[8 * s + 2], x[8 * s + 3]); p.z = pk_bf16(x[8 * s + 4], x[8 * s + 5]); p.w = pk_bf16(x[8 * s + 6], x[8 * s + 7]);
    return __builtin_bit_cast(bf16x8, p);
}
__device__ __forceinline__ bf16x8 ldperm(const bf16* p) {
    const u32x2 lo = *(const u32x2*)p, hi = *(const u32x2*)(p + 8);
    u32x4 v; v.x = lo.x; v.y = lo.y; v.z = hi.x; v.w = hi.y; return __builtin_bit_cast(bf16x8, v);
}
__device__ __forceinline__ bf16x8 ldnat(const bf16* p) { return __builtin_bit_cast(bf16x8, *(const u32x4*)p); }

struct Args { const float* in[16]; float* out; unsigned char* ws; int ph_lo, ph_hi; };
enum { I_X = 0, I_AWIN, I_ABG, I_AGH, I_AWOUT, I_BWQ, I_BREL, I_BWO, I_KVG, I_WKV, I_NMIX, I_NFFN, I_FG, I_FU, I_FD, I_FING };

struct Frame {
    LAS unsigned char* lds;
    int tid, lane, wave, G, bx;
    __device__ __forceinline__ int lane_now() const { int t_ = tid; asm volatile("" : "+v"(t_)); return t_ & 63; }
};

struct Job { const float* src; int ldw, K, col0, ncol; bf16* dst; int drow0, inter, dperm; const float* gain; float scale; };
constexpr int NJOBS = 30;
constexpr float QSCALE = 0.125f * LOG2E;
__device__ __forceinline__ Job make_job(const Args& A, int j) {
    Job o; unsigned char* ws = A.ws;
    o.inter = -1; o.dperm = 0; o.gain = nullptr; o.scale = 1.f; o.ldw = D; o.K = D; o.col0 = 0; o.ncol = D; o.drow0 = 0; o.src = nullptr; o.dst = nullptr;
    if (j < 12) {
        const int l = j / 6, t = j % 6;
        unsigned char* wb = ws + WS_WA + (size_t)l * WA_STRIDE;
        if (t < 5) {
            o.src = A.in[I_AWIN] + (size_t)l * D * AIN; o.ldw = AIN; o.gain = A.in[I_NMIX] + l * D;
            if (t == 0) { o.col0 = 0; o.ncol = 512; o.dst = (bf16*)(wb + WA_QKO); o.drow0 = 0; }
            else if (t == 1) { o.col0 = 512; o.ncol = 512; o.dst = (bf16*)(wb + WA_QKO); o.drow0 = 512; o.scale = 0.125f; }
            else if (t == 2) { o.col0 = 2048; o.ncol = 1024; o.dst = (bf16*)(wb + WA_QKO); o.drow0 = 1024; }
            else if (t == 3) { o.col0 = 512; o.ncol = 0; o.dst = (bf16*)(wb + WA_KV); o.drow0 = 0; }
            else { o.col0 = 1024; o.ncol = 1024; o.dst = (bf16*)(wb + WA_KV); o.drow0 = 0; }
        } else { o.src = A.in[I_AWOUT] + (size_t)l * D * D; o.dst = (bf16*)(wb + WA_OUT); }
    } else if (j < 18) {
        const int t = j - 12;
        if (t == 0) { o.src = A.in[I_BWQ]; o.dst = (bf16*)(ws + WS_WQK2); o.gain = A.in[I_NMIX] + 2 * D; o.scale = QSCALE; }
        else if (t == 1) { o.src = A.in[I_WKV]; o.ldw = 2 * D; o.col0 = 0; o.dst = (bf16*)(ws + WS_WQK2); o.drow0 = 1024; o.gain = A.in[I_KVG]; }
        else if (t == 2) { o.src = A.in[I_WKV]; o.ldw = 2 * D; o.col0 = 1024; o.dst = (bf16*)(ws + WS_WV); o.gain = A.in[I_KVG]; }
        else if (t == 3) { o.src = A.in[I_BWQ] + (size_t)D * D; o.dst = (bf16*)(ws + WS_WQ3); o.gain = A.in[I_NMIX] + 3 * D; o.scale = QSCALE; }
        else if (t == 4) { o.src = A.in[I_BWO]; o.dst = (bf16*)(ws + WS_WO); }
        else { o.src = A.in[I_BWO] + (size_t)D * D; o.dst = (bf16*)(ws + WS_WO + 2 * MiB); }
    } else {
        const int l = (j - 18) / 3, t = (j - 18) % 3;
        unsigned char* wb = ws + WS_WF + (size_t)l * WF_STRIDE;
        if (t == 0) { o.src = A.in[I_FG] + (size_t)l * D * FF; o.ldw = FF; o.ncol = FF; o.dst = (bf16*)wb; o.inter = 0; o.gain = A.in[I_NFFN] + l * D; }
        else if (t == 1) { o.src = A.in[I_FU] + (size_t)l * D * FF; o.ldw = FF; o.ncol = FF; o.dst = (bf16*)wb; o.inter = 1; o.gain = A.in[I_NFFN] + l * D; }
        else { o.src = A.in[I_FD] + (size_t)l * FF * D; o.ldw = D; o.K = FF; o.ncol = D; o.dst = (bf16*)(wb + WF_D); }
    }
    return o;
}
__device__ __forceinline__ void p0_transpose_item(const Job& jb, LAS float* scr, int item, int lane) {
    const int nblk = jb.ncol / 32, kb = item / nblk, nb = item % nblk, k0 = 64 * kb, n0 = 32 * nb;
    const float* W = jb.src + jb.col0 + n0;
    f32x4 wv[8];
#pragma unroll
    for (int i = 0; i < 8; ++i) wv[i] = __builtin_nontemporal_load((const f32x4*)(W + (size_t)(k0 + 8 * i + (lane >> 3)) * jb.ldw + 4 * (lane & 7)));
#pragma unroll
    for (int i = 0; i < 8; ++i) { const int kk = 8 * i + (lane >> 3); const float gg = (jb.gain ? jb.gain[k0 + kk] : 1.f) * jb.scale; LAS float* d = scr + kk * 33 + 4 * (lane & 7);
        d[0] = wv[i].x * gg; d[1] = wv[i].y * gg; d[2] = wv[i].z * gg; d[3] = wv[i].w * gg; }
    LDS_WAIT(); asm volatile("" ::: "memory");
    const int c = lane & 7;
    const int drow = jb.drow0 + (jb.inter >= 0 ? 256 * (n0 >> 7) + 128 * jb.inter + (n0 & 127) : n0);
#pragma unroll
    for (int j = 0; j < 4; ++j) { const int n = (lane >> 3) + 8 * j; const LAS float* s = scr + (8 * c) * 33 + n;
        const int nd = jb.dperm ? ((n & ~15) | ((n & 3) | ((n & 4) << 1) | ((n & 8) >> 1))) : n;
        u32x4 o; o.x = pk_bf16(s[0 * 33], s[1 * 33]); o.y = pk_bf16(s[2 * 33], s[3 * 33]); o.z = pk_bf16(s[4 * 33], s[5 * 33]); o.w = pk_bf16(s[6 * 33], s[7 * 33]);
        *(u32x4*)(jb.dst + (size_t)(drow + nd) * jb.K + k0 + 8 * c) = o; }
    LDS_WAIT(); asm volatile("" ::: "memory");
}
__device__ __forceinline__ void p0_prologue(const Frame& F, const Args& A) {
    const int lane0 = F.lane_now();
    LAS float* scr = (LAS float*)(F.lds + F.wave * 16384);
    const int gw = F.bx * NWAVES + F.wave, NGW = F.G * NWAVES;
    int off = 0;
    for (int j = 0; j < NJOBS; ++j) {
        const Job jb = make_job(A, j);
        const int n = (jb.K / 64) * (jb.ncol / 32);
        int first = (gw - off) % NGW; if (first < 0) first += NGW;
        for (int r = first; r < n; r += NGW) p0_transpose_item(jb, scr, r, lane0);
        off += n;
    }
    for (int e = (F.bx * NWAVES * 64 + F.tid); e < 2 * 16 * D; e += F.G * NWAVES * 64) {
        const int l = e / (16 * D), j = (e / D) % 16, k = e % D;
        const float w = A.in[I_AWIN][(size_t)l * D * AIN + (size_t)k * AIN + 3072 + j] * A.in[I_NMIX][l * D + k];
        ((bf16*)(A.ws + WS_WA + (size_t)l * WA_STRIDE + WA_G))[j * D + k] = (bf16)(pk_bf16(w, 0.f) & 0xffffu);
    }
}

__device__ __forceinline__ void xconv_phase(const Frame& F, const float* x, bf16* h, u64* ssq) {
    const int lane0 = F.lane_now();
    const int gw = F.bx * NWAVES + F.wave, NGW = F.G * NWAVES;
    for (int m = gw; m < M; m += NGW) {
        const f32x4* xr = (const f32x4*)(x + (size_t)m * D) + lane0;
        f32x4 v[4]; float s = 0.f;
#pragma unroll
        for (int j = 0; j < 4; ++j) { v[j] = __builtin_nontemporal_load(xr + 64 * j); s += (v[j].x * v[j].x + v[j].y * v[j].y) + (v[j].z * v[j].z + v[j].w * v[j].w); }
        s = wave_sum(s);
        if (lane0 == 0) ssq[m] = (u64)(s * SSQ_FIX);
        u32x2* o8 = (u32x2*)(h + (size_t)m * D) + lane0;
#pragma unroll
        for (int j = 0; j < 4; ++j) { u32x2 w; w.x = pk_bf16(v[j].x, v[j].y); w.y = pk_bf16(v[j].z, v[j].w); o8[64 * j] = w; }
    }
}
__device__ __forceinline__ void final_norm_phase(const Frame& F, const bf16* h, const u64* ssq, const float* g, float* out) {
    const int lane0 = F.lane_now();
    const int gw = F.bx * NWAVES + F.wave, NGW = F.G * NWAVES;
    f32x4 gv[4];
#pragma unroll
    for (int j = 0; j < 2; ++j) { gv[2 * j] = *(const f32x4*)(g + 512 * j + 8 * lane0); gv[2 * j + 1] = *(const f32x4*)(g + 512 * j + 8 * lane0 + 4); }
    for (int m = gw; m < M; m += NGW) {
        const bf16* hr = h + (size_t)m * D + 8 * lane0;
        const u32x4 h0 = __builtin_nontemporal_load((const u32x4*)hr), h1 = __builtin_nontemporal_load((const u32x4*)(hr + 512));
        const float rstd = 1.f / sqrtf((float)ssq[m] * (1.0f / (1048576.0f * 1024.0f)) + EPS);
        float* orow = out + (size_t)m * D + 8 * lane0;
        f32x4 v;
        v.x = bf_lo(h0.x); v.y = bf_hi(h0.x); v.z = bf_lo(h0.y); v.w = bf_hi(h0.y); __builtin_nontemporal_store(v * rstd * gv[0], (f32x4*)(orow));
        v.x = bf_lo(h0.z); v.y = bf_hi(h0.z); v.z = bf_lo(h0.w); v.w = bf_hi(h0.w); __builtin_nontemporal_store(v * rstd * gv[1], (f32x4*)(orow + 4));
        v.x = bf_lo(h1.x); v.y = bf_hi(h1.x); v.z = bf_lo(h1.y); v.w = bf_hi(h1.y); __builtin_nontemporal_store(v * rstd * gv[2], (f32x4*)(orow + 512));
        v.x = bf_lo(h1.z); v.y = bf_hi(h1.z); v.z = bf_lo(h1.w); v.w = bf_hi(h1.w); __builtin_nontemporal_store(v * rstd * gv[3], (f32x4*)(orow + 516));
    }
}

__device__ __forceinline__ void gates_phase(const Frame& F, const bf16* h, const u64* ssq, const bf16* wg, const float* bgate, float* gt) {
    const int gw = F.bx * NWAVES + F.wave, NGW = F.G * NWAVES;
    const int lane_ = F.lane_now();
    const int r16 = lane_ & 15, kg = lane_ >> 4;
    const float bias = bgate[r16];
    for (int it = gw; it < M / 16; it += NGW) {
        const bf16* ap = h + (size_t)(it * 16 + r16) * D + 8 * kg;
        const bf16* bp = wg + (size_t)r16 * D + 8 * kg;
        f32x4 acc = {0.f, 0.f, 0.f, 0.f};
#pragma unroll 8
        for (int s = 0; s < D / 32; ++s) acc = __builtin_amdgcn_mfma_f32_16x16x32_bf16(ldnat(ap + 32 * s), ldnat(bp + 32 * s), acc, 0, 0, 0);
        f32x4 o;
#pragma unroll
        for (int e = 0; e < 4; ++e) o[e] = acc[e] * rstd_of(ssq[it * 16 + 4 * kg + e]) + bias;
        *(f32x4*)(gt + (size_t)r16 * M + it * 16 + 4 * kg) = o;
    }
}

#define DPP_SCAN_STEP_ADD(v_, ctrl_, rm_) v_ += __int_as_float(__builtin_amdgcn_update_dpp(0, __float_as_int(v_), ctrl_, rm_, 0xf, true))
#define DPP_SCAN_STEP_MAX(v_, ctrl_, rm_) v_ = fmaxf(v_, __int_as_float(__builtin_amdgcn_update_dpp((int)0xff800000u, __float_as_int(v_), ctrl_, rm_, 0xf, false)))
__device__ __forceinline__ float wave_scan_add(float v) {
    DPP_SCAN_STEP_ADD(v, 0x111, 0xf); DPP_SCAN_STEP_ADD(v, 0x112, 0xf); DPP_SCAN_STEP_ADD(v, 0x114, 0xf); DPP_SCAN_STEP_ADD(v, 0x118, 0xf);
    DPP_SCAN_STEP_ADD(v, 0x142, 0xa); DPP_SCAN_STEP_ADD(v, 0x143, 0xc); return v; }
__device__ __forceinline__ float wave_scan_max(float v) {
    DPP_SCAN_STEP_MAX(v, 0x111, 0xf); DPP_SCAN_STEP_MAX(v, 0x112, 0xf); DPP_SCAN_STEP_MAX(v, 0x114, 0xf); DPP_SCAN_STEP_MAX(v, 0x118, 0xf);
    DPP_SCAN_STEP_MAX(v, 0x142, 0xa); DPP_SCAN_STEP_MAX(v, 0x143, 0xc); return v; }
__device__ __forceinline__ float half_bcast(float x, int sel) { const auto rr = __builtin_amdgcn_permlane32_swap(__float_as_uint(x), __float_as_uint(x), false, false); return __uint_as_float(sel ? rr[1] : rr[0]); }
typedef short v4i16_t __attribute__((ext_vector_type(4)));
constexpr int ML_Q = 0, ML_K = 8192, ML_VT = 16384, ML_OP = 32768, ML_BUF = 49152;
constexpr int ML_KS = 2 * ML_BUF, ML_SCR = ML_KS + 8192, ML_SSQ = ML_SCR + 8192;
constexpr int ML_GL = 118784;
constexpr int ML_OT = pg8::EPI_T_OFF;
static_assert(ML_SSQ + 2048 + 512 <= ML_GL && ML_GL + 2 * SEQ * 4 <= ML_OT && ML_SSQ + 2048 + 512 <= RING_BYTES && ML_OT + 8 * 32 * 80 <= LDSCTL_OFF && pg8::EPI_T_OFF + 8 * pg8::EPI_T_WAVE <= LDSCTL_OFF, "mLSTM / GEMM LDS map");
__device__ __forceinline__ void mlstm_phase(const Frame& F, const bf16* qko, const bf16* vtg, const float* gates, const float* ghead, bf16* hs) {
    const int lane_ = F.lane_now();
    const int w = F.wave, lane = lane_, r = lane & 31, hh = lane >> 5, vblk = w & 3, tblk = w >> 2;
    LAS float* Gs = (LAS float*)(F.lds + ML_SCR + w * 1024);
    LAS float* WAs = Gs + 64;
    LAS float* SSQ = (LAS float*)(F.lds + ML_SSQ);
    const int xs = (r >> 1) & 7;
    const int foff0 = r * 128 + (((0 + hh) ^ xs) << 4), foff1 = r * 128 + (((2 + hh) ^ xs) << 4), foff2 = r * 128 + (((4 + hh) ^ xs) << 4), foff3 = r * 128 + (((6 + hh) ^ xs) << 4);
    const int qpo0 = r * 128 + 8 * hh;
    const int tq = (lane & 15) >> 2, tp = lane & 3, tg = (lane >> 4) & 1;
    const int t = 32 * tblk + r;
    const bf16x8 ONES = __builtin_bit_cast(bf16x8, (u32x4){0x3F803F80u, 0x3F803F80u, 0x3F803F80u, 0x3F803F80u});
#define ML_DMA(g_, off_) __builtin_amdgcn_global_load_lds((const unsigned*)(g_), (LAS unsigned*)(bufp + (off_)), 16, 0, 0)
#define ML_ISSUE(cc_) do { const size_t tk_ = (size_t)b * SEQ + (size_t)(cc_) * CH; LAS unsigned char* bufp = F.lds + ((cc_) & 1) * ML_BUF + w * 1024; \
        int l2_ = lane; asm volatile("" : "+v"(l2_));        \
        const int r8_ = 8 * w + (l2_ >> 3), c8_ = (l2_ & 7) ^ ((r8_ >> 1) & 7), r4a_ = 4 * w + (l2_ >> 4), c4a_ = (l2_ & 15) ^ (r4a_ & 15), r4b_ = r4a_ + 32, c4b_ = (l2_ & 15) ^ (r4b_ & 15); \
        ML_DMA(qko + (tk_ + r8_) * 2048 + h * DQK + c8_ * 8, ML_Q); \
        ML_DMA(qko + (tk_ + r8_) * 2048 + 512 + h * DQK + c8_ * 8, ML_K); \
        ML_DMA(vtg + (size_t)(h * DV + r8_) * M + tk_ + c8_ * 8, ML_VT); \
        ML_DMA(vtg + (size_t)(h * DV + 64 + r8_) * M + tk_ + c8_ * 8, ML_VT + 8192); \
        ML_DMA(qko + (tk_ + r4a_) * 2048 + 1024 + h * DV + c4a_ * 8, ML_OP); \
        ML_DMA(qko + (tk_ + r4b_) * 2048 + 1024 + h * DV + c4b_ * 8, ML_OP + 8192); } while (0)
#define ML_FRAG(off_) (*(const LAS bf16x8*)(buf + (off_)))
    if (w >= 4) __builtin_amdgcn_s_setprio(1);
    for (int bh = F.bx; bh < NBATCH * AH; bh += F.G) {
        const int b = bh / AH, h = bh % AH;
        asm volatile("s_waitcnt vmcnt(0) lgkmcnt(0)" ::: "memory"); __builtin_amdgcn_s_barrier(); asm volatile("" ::: "memory");
        f32x16 Ct0 = zero16(), Ct1 = zero16(), Nt0 = zero16(), Nt1 = zero16();
        float m_state = -1e30f;
        LAS float* GH = (LAS float*)(F.lds + ML_SSQ + 2048);
        if (F.tid < DV) GH[F.tid] = ghead[h * DV + F.tid];
        LAS float* GL = (LAS float*)(F.lds + ML_GL);
        { const f32x4 vi = *(const f32x4*)(gates + (size_t)h * M + (size_t)b * SEQ + 4 * F.tid), vf = *(const f32x4*)(gates + (size_t)(8 + h) * M + (size_t)b * SEQ + 4 * F.tid);
          *(LAS f32x4*)(GL + 4 * F.tid) = vi; *(LAS f32x4*)(GL + SEQ + 4 * F.tid) = vf; }
        asm volatile("s_waitcnt vmcnt(0) lgkmcnt(0)" ::: "memory"); __builtin_amdgcn_s_barrier(); asm volatile("" ::: "memory");
        ML_ISSUE(0);
        for (int c = 0; c < NCH; ++c) {
            const size_t tok0 = (size_t)b * SEQ + (size_t)c * CH;
            const LAS unsigned char* buf = F.lds + (c & 1) * ML_BUF;
            const float ipre = GL[c * CH + lane] * LOG2E, fpre = GL[SEQ + c * CH + lane];
            const float flog = (fminf(fpre, 0.f) - __logf(1.f + __expf(-fabsf(fpre)))) * LOG2E;
            const float bc = wave_scan_add(flog);
            const float gs = ipre - bc;
            const float pm = wave_scan_max(gs);
            const float Mt = fmaxf(m_state, pm);
            const float bL = __int_as_float(__builtin_amdgcn_readlane(__float_as_int(bc), 63)), M63 = __int_as_float(__builtin_amdgcn_readlane(__float_as_int(Mt), 63));
            const float wa = fast_exp2(gs - M63);
            const float decay = fast_exp2(m_state - M63);
            const float wint_l = fast_exp2(m_state - Mt), floor_l = fast_exp2(-bc - Mt);
            Gs[lane] = gs; WAs[lane] = wa;
            const float Mt_t = half_bcast(Mt, tblk), wint = half_bcast(wint_l, tblk), floorv = half_bcast(floor_l, tblk);
            if (c == 0) asm volatile("s_waitcnt vmcnt(0) lgkmcnt(0)" ::: "memory"); else asm volatile("s_waitcnt vmcnt(2) lgkmcnt(0)" ::: "memory");
            __builtin_amdgcn_s_barrier(); asm volatile("" ::: "memory");
            if (c + 1 < NCH) { ML_ISSUE(c + 1); }
            bf16x8 qp[4];
#pragma unroll
            for (int f = 0; f < 4; ++f) { const u32x2 lo = *(const LAS u32x2*)(buf + ML_Q + tblk * 4096 + qpo0 + (((2 * f) ^ xs) << 4)), hi = *(const LAS u32x2*)(buf + ML_Q + tblk * 4096 + qpo0 + (((2 * f + 1) ^ xs) << 4));
                u32x4 v; v.x = lo.x; v.y = lo.y; v.z = hi.x; v.w = hi.y; qp[f] = __builtin_bit_cast(bf16x8, v); }
            f32x16 accd = zero16(), acc = zero16();
            accd = mfma32(pack8(Nt0, 0), qp[0], accd); acc = mfma32(pack8(Ct0, 0), qp[0], acc); accd = mfma32(pack8(Nt0, 1), qp[1], accd); acc = mfma32(pack8(Ct0, 1), qp[1], acc);
            accd = mfma32(pack8(Nt1, 0), qp[2], accd); acc = mfma32(pack8(Ct1, 0), qp[2], acc); accd = mfma32(pack8(Nt1, 1), qp[3], accd); acc = mfma32(pack8(Ct1, 1), qp[3], acc);
            __builtin_amdgcn_sched_barrier(0);
            const bf16x8 qf0 = ML_FRAG(ML_Q + tblk * 4096 + foff0), qf1 = ML_FRAG(ML_Q + tblk * 4096 + foff1), qf2 = ML_FRAG(ML_Q + tblk * 4096 + foff2), qf3 = ML_FRAG(ML_Q + tblk * 4096 + foff3);
            f32x16 S0 = zero16(), S1 = zero16();
            S0 = mfma32(ML_FRAG(ML_K + foff0), qf0, S0); S0 = mfma32(ML_FRAG(ML_K + foff1), qf1, S0); S0 = mfma32(ML_FRAG(ML_K + foff2), qf2, S0); S0 = mfma32(ML_FRAG(ML_K + foff3), qf3, S0);
            if (tblk == 1) { S1 = mfma32(ML_FRAG(ML_K + 4096 + foff0), qf0, S1); S1 = mfma32(ML_FRAG(ML_K + 4096 + foff1), qf1, S1); S1 = mfma32(ML_FRAG(ML_K + 4096 + foff2), qf2, S1); S1 = mfma32(ML_FRAG(ML_K + 4096 + foff3), qf3, S1); }
            {
                const u32x4 kraw = *(const LAS u32x4*)(buf + ML_K + w * 1024 + lane * 16);
                const float was = WAs[8 * w + (lane >> 3)];
                u32x4 ko; ko.x = pk_bf16(bf_lo(kraw.x) * was, bf_hi(kraw.x) * was); ko.y = pk_bf16(bf_lo(kraw.y) * was, bf_hi(kraw.y) * was);
                ko.z = pk_bf16(bf_lo(kraw.z) * was, bf_hi(kraw.z) * was); ko.w = pk_bf16(bf_lo(kraw.w) * was, bf_hi(kraw.w) * was);
                *(LAS u32x4*)(F.lds + ML_KS + w * 1024 + lane * 16) = ko;
            }
            if (tblk == 0) {
#pragma unroll
                for (int g4 = 0; g4 < 4; ++g4) { const f32x4 ga = *(const LAS f32x4*)(Gs + 8 * g4 + 4 * hh);
#pragma unroll
                    for (int e = 0; e < 4; ++e) { const int s0 = 8 * g4 + 4 * hh + e; S0[4 * g4 + e] = (s0 <= t) ? S0[4 * g4 + e] * fast_exp2(ga[e] - Mt_t) : 0.f; } }
            } else {
#pragma unroll
                for (int g4 = 0; g4 < 4; ++g4) { const f32x4 ga = *(const LAS f32x4*)(Gs + 8 * g4 + 4 * hh); const f32x4 gb = *(const LAS f32x4*)(Gs + 32 + 8 * g4 + 4 * hh);
#pragma unroll
                    for (int e = 0; e < 4; ++e) { const int s1 = 32 + 8 * g4 + 4 * hh + e; S0[4 * g4 + e] = S0[4 * g4 + e] * fast_exp2(ga[e] - Mt_t);
                        S1[4 * g4 + e] = (s1 <= t) ? S1[4 * g4 + e] * fast_exp2(gb[e] - Mt_t) : 0.f; } }
            }
            const bf16x8 p0 = pack8(S0, 0), p1 = pack8(S0, 1), p2 = pack8(S1, 0), p3 = pack8(S1, 1);
            __builtin_amdgcn_sched_barrier(0);
            f32x16 accs = zero16();
            accs = mfma32(ONES, p0, accs); accs = mfma32(ONES, p1, accs);
            if (tblk == 1) { accs = mfma32(ONES, p2, accs); accs = mfma32(ONES, p3, accs); }
#pragma unroll
            for (int i = 0; i < 16; ++i) acc[i] *= wint;
            { const bf16x8 vf0 = ML_FRAG(ML_VT + vblk * 4096 + foff0), vf1 = ML_FRAG(ML_VT + vblk * 4096 + foff1);
              acc = mfma32(vf0, p0, acc); acc = mfma32(vf1, p1, acc); }
            if (tblk == 1) { const bf16x8 vf2 = ML_FRAG(ML_VT + vblk * 4096 + foff2), vf3 = ML_FRAG(ML_VT + vblk * 4096 + foff3); acc = mfma32(vf2, p2, acc); acc = mfma32(vf3, p3, acc); }
            const float den = accs[0] + accd[0] * wint;
            const float inv = fast_rcp(fmaxf(fabsf(den), floorv));
            float sq = 0.f;
#pragma unroll
            for (int i = 0; i < 16; ++i) { acc[i] *= inv; sq += acc[i] * acc[i]; }
            sq = xhalf_sum(sq);
            LAS float* sqp = SSQ + (c & 1) * 256;
            if (hh == 0) sqp[vblk * 64 + t] = sq;
            asm volatile("s_waitcnt lgkmcnt(0)" ::: "memory"); __builtin_amdgcn_s_barrier(); asm volatile("" ::: "memory");
            const float tot = (sqp[t] + sqp[64 + t]) + (sqp[128 + t] + sqp[192 + t]);
            const float rinv = __builtin_amdgcn_rsqf(tot * (1.f / DV) + EPS);
            LAS unsigned char* otw = F.lds + ML_OT + w * (32 * 80) + r * 80 + 8 * hh;
            u32x4 ov4a[4]; f32x4 ghva[4];
#pragma unroll
            for (int gq = 0; gq < 4; ++gq) { ov4a[gq] = *(const LAS u32x4*)(buf + ML_OP + t * 256 + (((4 * vblk + gq) ^ (t & 15)) << 4)); ghva[gq] = *(const LAS f32x4*)(GH + 32 * vblk + 8 * gq + 4 * hh); }
#pragma unroll
            for (int gq = 0; gq < 4; ++gq) {
                const u32x4 ov4 = ov4a[gq]; const f32x4 ghv = ghva[gq];
                const unsigned ox = hh ? ov4.z : ov4.x, oy = hh ? ov4.w : ov4.y;
                const float o0 = bf_lo(ox), o1 = bf_hi(ox), o2 = bf_lo(oy), o3 = bf_hi(oy);
                const float y0 = acc[4 * gq + 0] * rinv * ghv[0] * fast_rcp(1.f + fast_exp(-o0));
                const float y1 = acc[4 * gq + 1] * rinv * ghv[1] * fast_rcp(1.f + fast_exp(-o1));
                const float y2 = acc[4 * gq + 2] * rinv * ghv[2] * fast_rcp(1.f + fast_exp(-o2));
                const float y3 = acc[4 * gq + 3] * rinv * ghv[3] * fast_rcp(1.f + fast_exp(-o3));
                u32x2 wv; wv.x = pk_bf16(y0, y1); wv.y = pk_bf16(y2, y3);
                *(LAS u32x2*)(otw + 16 * gq) = wv;
            }
            asm volatile("" ::: "memory");
            {
                const LAS unsigned char* otr = F.lds + ML_OT + w * (32 * 80) + (lane >> 2) * 80 + (lane & 3) * 16;
                bf16* hp = hs + (tok0 + 32 * tblk + (lane >> 2)) * D + h * DV + 32 * vblk + 8 * (lane & 3);
                const u32x4 oa = *(const LAS u32x4*)otr, ob = *(const LAS u32x4*)(otr + 16 * 80);
                __builtin_nontemporal_store(oa, (u32x4*)hp); __builtin_nontemporal_store(ob, (u32x4*)(hp + (size_t)16 * D));
            }
#pragma unroll
            for (int i = 0; i < 16; ++i) { Ct0[i] *= decay; Ct1[i] *= decay; Nt0[i] *= decay; Nt1[i] *= decay; }
            {
                const bf16x8 vfs[4] = {ML_FRAG(ML_VT + vblk * 4096 + foff0), ML_FRAG(ML_VT + vblk * 4096 + foff1), ML_FRAG(ML_VT + vblk * 4096 + foff2), ML_FRAG(ML_VT + vblk * 4096 + foff3)};
                const LAS unsigned char* ks = F.lds + ML_KS;
#pragma unroll
                for (int db = 0; db < 2; ++db) {
#pragma unroll
                    for (int f = 0; f < 4; ++f) {
                        const int sa = 16 * f + 4 * hh + tq, sb2 = sa + 8, ch = 4 * db + 2 * tg + (tp >> 1);
                        const v4i16_t lo = __builtin_amdgcn_ds_read_tr16_b64_v4i16((LAS v4i16_t*)(ks + sa * 128 + ((ch ^ ((sa >> 1) & 7)) << 4) + 8 * (tp & 1)));
                        const v4i16_t hi = __builtin_amdgcn_ds_read_tr16_b64_v4i16((LAS v4i16_t*)(ks + sb2 * 128 + ((ch ^ ((sb2 >> 1) & 7)) << 4) + 8 * (tp & 1)));
                        const bf16x8 kf = __builtin_shufflevector(lo, hi, 0, 1, 2, 3, 4, 5, 6, 7);
                        if (db == 0) { Ct0 = mfma32(kf, vfs[f], Ct0); Nt0 = mfma32(kf, ONES, Nt0); } else { Ct1 = mfma32(kf, vfs[f], Ct1); Nt1 = mfma32(kf, ONES, Nt1); }
                    }
                }
            }
            m_state = bL + M63;
        }
        asm volatile("s_waitcnt vmcnt(0) lgkmcnt(0)" ::: "memory"); __builtin_amdgcn_s_barrier(); asm volatile("" ::: "memory");
    }
    __builtin_amdgcn_s_setprio(0);
#undef ML_DMA
#undef ML_ISSUE
#undef ML_FRAG
}

constexpr int AT_TBL = 0, AT_TBLN = 832;
constexpr int AT_RING = 8192, AT_SLOT = 32768, AT_QOFF = AT_RING + 3 * AT_SLOT, AT_OOFF = AT_QOFF + 8 * 4096;
constexpr int AT_STEPS = 42;
static_assert(AT_OOFF + 8 * 16 * 144 <= LDSCTL_OFF, "attention LDS map");
__device__ __forceinline__ void attn_decode(int rem, int& cg, int& kc) {
    if (rem < 2) { cg = 0; kc = 2 * rem; } else if (rem < 6) { cg = 1; kc = 2 * (rem - 2); } else { const int q = (rem - 6) / 6; cg = 2 + q; kc = 4 * cg - 8 + 2 * ((rem - 6) - 6 * q); }
}
__device__ __forceinline__ void attn_phase(const Frame& F, const bf16* qb, const bf16* kb, const bf16* vt, const float* rel, bf16* ao) {
    const int lane_ = F.lane_now();
    const int w = F.wave, lane = lane_, r = lane & 31, hh = lane >> 5, half = w & 1, co = w >> 1;
    LAS float* TB = (LAS float*)(F.lds + AT_TBL);
    LAS unsigned char* ringp = F.lds + AT_RING;
    const int xs = (r >> 1) & 7;
    const int foff0 = r * 128 + (((0 + hh) ^ xs) << 4), foff1 = r * 128 + (((2 + hh) ^ xs) << 4), foff2 = r * 128 + (((4 + hh) ^ xs) << 4), foff3 = r * 128 + (((6 + hh) ^ xs) << 4);
    const int t = 32 * half + r;
    constexpr int NS = 2 * AT_STEPS;
#define AT_ISSUE(n_) do { const int nn_ = (n_) < NS ? (n_) : NS - 1; const int pi_ = nn_ / AT_STEPS; int cg_, kc_; attn_decode(nn_ - pi_ * AT_STEPS, cg_, kc_); \
        int l3_ = lane; asm volatile("" : "+v"(l3_));        \
        const int P = w * 64 + l3_, srow = P >> 3, scol = (P & 7) ^ ((srow >> 1) & 7); \
        const int bh_ = 2 * pr + pi_, b_ = bh_ / BH, hd_ = bh_ % BH; \
        LAS unsigned char* dst_ = ringp + ((n_) % 3) * AT_SLOT + w * 1024; \
        _Pragma("unroll") for (int tt_ = 0; tt_ < 2; ++tt_) { const size_t kt_ = (size_t)b_ * SEQ + (size_t)(kc_ + tt_) * CH; \
            const bf16* gk_ = kb + (kt_ + srow) * D + hd_ * DHD + scol * 8; const bf16* gv_ = vt + (size_t)(hd_ * DHD + srow) * M + kt_ + scol * 8; \
            __builtin_amdgcn_global_load_lds((const unsigned*)gk_, (LAS unsigned*)(dst_ + tt_ * 16384), 16, 0, 0); \
            __builtin_amdgcn_global_load_lds((const unsigned*)gv_, (LAS unsigned*)(dst_ + tt_ * 16384 + 8192), 16, 0, 0); } } while (0)
#define AT_QDMA(pi_, cg_) do { const int bh_ = 2 * pr + (pi_), b_ = bh_ / BH, hd_ = bh_ % BH; \
        const bf16* qp_ = qb + ((size_t)b_ * SEQ + (size_t)(4 * (cg_) + co) * CH + 32 * half) * D + hd_ * DHD; \
        _Pragma("unroll") for (int i_ = 0; i_ < 4; ++i_) { const int row_ = 8 * i_ + (lane >> 3), col_ = (lane & 7) ^ ((row_ >> 1) & 7); \
            __builtin_amdgcn_global_load_lds((const unsigned*)(qp_ + (size_t)row_ * D + col_ * 8), (LAS unsigned*)(qlds + i_ * 1024), 16, 0, 0); } } while (0)
#define AT_SCORES(S_0, S_1, so_, j_) do { \
        const LAS unsigned char* a0_ = sl + (so_) + foff0; const LAS unsigned char* a1_ = sl + (so_) + foff1; const LAS unsigned char* a2_ = sl + (so_) + foff2; const LAS unsigned char* a3_ = sl + (so_) + foff3; \
        bf16x8 kf0 = *(const LAS bf16x8*)(a0_), kf1 = *(const LAS bf16x8*)(a1_), kf2 = *(const LAS bf16x8*)(a2_), kf3 = *(const LAS bf16x8*)(a3_); \
        bf16x8 kf4 = *(const LAS bf16x8*)(a0_ + 4096), kf5 = *(const LAS bf16x8*)(a1_ + 4096), kf6 = *(const LAS bf16x8*)(a2_ + 4096), kf7 = *(const LAS bf16x8*)(a3_ + 4096); \
        const LAS float* pb_ = tb + (AT_TBLN - 1 - ((8 - (j_)) * 64 + t + 256 - 4 * hh)); \
        asm volatile("" : "+v"(pb_)); \
        _Pragma("unroll") for (int i = 0; i < 16; ++i) { const int ci = (i & 3) + 8 * (i >> 2); S_0[i] = pb_[ci]; S_1[i] = pb_[ci + 32]; } \
        asm volatile("" : "+v"(kf0), "+v"(kf1), "+v"(kf2), "+v"(kf3), "+v"(kf4), "+v"(kf5), "+v"(kf6), "+v"(kf7), "+v"(S_0), "+v"(S_1)); \
        S_0 = mfma32(kf0, qf[0], S_0); S_1 = mfma32(kf4, qf[0], S_1); S_0 = mfma32(kf1, qf[1], S_0); S_1 = mfma32(kf5, qf[1], S_1); \
        S_0 = mfma32(kf2, qf[2], S_0); S_1 = mfma32(kf6, qf[2], S_1); S_0 = mfma32(kf3, qf[3], S_0); S_1 = mfma32(kf7, qf[3], S_1); } while (0)
#define AT_SOFTPV(S_0, S_1, so_, first_) do { \
        float mx = -3.0e38f; \
        _Pragma("unroll") for (int i = 0; i < 16; ++i) asm("v_max3_f32 %0, %1, %2, %3" : "=v"(mx) : "v"(mx), "v"(S_0[i]), "v"(S_1[i])); \
        mx = xhalf_max(mx); \
        const float dmx = mx - m_run; \
        const bool need = (first_) ? (fabsf(mx) > 32.f) : (dmx > 64.f); \
        if (__any(need)) { \
            const float dm = need ? dmx : 0.f; \
            const float alpha = (first_) ? 1.f : fast_exp2(-dm); \
            m_run += dm; lsum *= alpha; \
            _Pragma("unroll") for (int i = 0; i < 16; ++i) { O0[i] *= alpha; O1[i] *= alpha; } \
            mnz = __any(m_run != 0.f); \
        } \
        if (mnz) { \
            _Pragma("unroll") for (int i = 0; i < 16; ++i) { S_0[i] -= m_run; S_1[i] -= m_run; } \
        } \
        const LAS unsigned char* v0_ = sl + (so_) + 8192 + foff0; const LAS unsigned char* v1_ = sl + (so_) + 8192 + foff1; const LAS unsigned char* v2_ = sl + (so_) + 8192 + foff2; const LAS unsigned char* v3_ = sl + (so_) + 8192 + foff3; \
        bf16x8 vf0 = *(const LAS bf16x8*)(v0_), vf1 = *(const LAS bf16x8*)(v1_), vf2 = *(const LAS bf16x8*)(v2_), vf3 = *(const LAS bf16x8*)(v3_); \
        bf16x8 vf4 = *(const LAS bf16x8*)(v0_ + 4096), vf5 = *(const LAS bf16x8*)(v1_ + 4096), vf6 = *(const LAS bf16x8*)(v2_ + 4096), vf7 = *(const LAS bf16x8*)(v3_ + 4096); \
        __builtin_amdgcn_sched_barrier(0); \
        float ps = 0.f; \
        _Pragma("unroll") for (int i = 0; i < 16; ++i) { S_0[i] = fast_exp2(S_0[i]); S_1[i] = fast_exp2(S_1[i]); ps += S_0[i] + S_1[i]; } \
        lsum += ps; \
        const bf16x8 p0 = pack8(S_0, 0), p1 = pack8(S_0, 1), p2 = pack8(S_1, 0), p3 = pack8(S_1, 1); \
        asm volatile("" : "+v"(vf0), "+v"(vf1), "+v"(vf2), "+v"(vf3), "+v"(vf4), "+v"(vf5), "+v"(vf6), "+v"(vf7)); \
        O0 = mfma32(vf0, p0, O0); O1 = mfma32(vf4, p0, O1); O0 = mfma32(vf1, p1, O0); O1 = mfma32(vf5, p1, O1); \
        O0 = mfma32(vf2, p2, O0); O1 = mfma32(vf6, p2, O1); O0 = mfma32(vf3, p3, O0); O1 = mfma32(vf7, p3, O1); } while (0)
    LAS unsigned char* qlds = F.lds + AT_QOFF + w * 4096;
    LAS unsigned char* otl = F.lds + AT_OOFF + w * (16 * 144);
    for (int pr = F.bx; pr < NBATCH * BH / 2; pr += F.G) {
        asm volatile("s_waitcnt vmcnt(0) lgkmcnt(0)" ::: "memory"); __builtin_amdgcn_s_barrier(); asm volatile("" ::: "memory");
        for (int e = F.tid; e < 2 * AT_TBLN; e += NWAVES * 64) { const int pi = e / AT_TBLN, ix = AT_TBLN - 1 - e % AT_TBLN; const int hd = (2 * pr + pi) % BH; TB[e] = rel[hd * NREL + (ix < 512 ? ix : 512)] * LOG2E; }
        asm volatile("s_waitcnt vmcnt(0) lgkmcnt(0)" ::: "memory"); __builtin_amdgcn_s_barrier(); asm volatile("" ::: "memory");
        AT_QDMA(0, 0);
        asm volatile("s_waitcnt vmcnt(0)" ::: "memory");
        AT_ISSUE(0); AT_ISSUE(1);
        bf16x8 qf[4];
        f32x16 O0 = zero16(), O1 = zero16();
        float m_run = 0.f, lsum = 0.f;
        bool mnz = false;
        int e_prev = 0;
        for (int n = 0; n < NS; ++n) {
            const int pi = n / AT_STEPS; int cg, kc; attn_decode(n - pi * AT_STEPS, cg, kc);
            const int c = 4 * cg + co;
            if (e_prev == 0) asm volatile("s_waitcnt vmcnt(4)" ::: "memory"); else if (e_prev == 1) asm volatile("s_waitcnt vmcnt(8)" ::: "memory"); else asm volatile("s_waitcnt vmcnt(12)" ::: "memory");
            __builtin_amdgcn_s_barrier(); asm volatile("" ::: "memory");
            e_prev = 0;
            AT_ISSUE(n + 2);
            const int kfirst = c < 8 ? 0 : c - 8;
            const bool actA = (kc >= kfirst && kc <= c), actB = (kc + 1 >= kfirst && kc + 1 <= c);
            if (kc == kfirst || kc + 1 == kfirst) {
                qf[0] = *(const LAS bf16x8*)(qlds + foff0); qf[1] = *(const LAS bf16x8*)(qlds + foff1); qf[2] = *(const LAS bf16x8*)(qlds + foff2); qf[3] = *(const LAS bf16x8*)(qlds + foff3);
                O0 = zero16(); O1 = zero16(); m_run = 0.f; lsum = 0.f; mnz = false;
                int npi = pi, ncg = cg + 1; if (ncg == 8) { ncg = 0; npi = pi + 1; }
                asm volatile("s_waitcnt lgkmcnt(0)" ::: "memory");
                if (npi < 2) { AT_QDMA(npi, ncg); e_prev += 1; }
            }
            if (actA || actB) {
                const LAS float* tb = TB + pi * AT_TBLN;
                const LAS unsigned char* sl = ringp + (n % 3) * AT_SLOT;
                const int jA = kc - (c - 8);
                f32x16 SA0, SA1, SB0, SB1;
                if (actA) AT_SCORES(SA0, SA1, 0, jA);
                if (actB) AT_SCORES(SB0, SB1, 16384, jA + 1);
                if (actA) AT_SOFTPV(SA0, SA1, 0, kc == kfirst);
                if (actB) AT_SOFTPV(SB0, SB1, 16384, kc + 1 == kfirst);
                if (kc == c || kc + 1 == c) {
                    const float ltot = xhalf_sum(lsum);
                    const float inv = 1.f / ltot;
                    const int bh = 2 * pr + pi, b = bh / BH, hd = bh % BH;
                    LAS unsigned char* tw = otl + (r & 15) * 144 + 8 * hh;
                    bf16* op = ao + ((size_t)b * SEQ + (size_t)c * CH + 32 * half + (lane >> 3)) * D + hd * DHD + 8 * (lane & 7);
                    const LAS unsigned char* tr = otl + (lane >> 3) * 144 + (lane & 7) * 16;
#pragma unroll
                    for (int ps2 = 0; ps2 < 2; ++ps2) {
                        if ((r >> 4) == ps2) {
#pragma unroll
                            for (int gq = 0; gq < 4; ++gq) {
                                u32x2 w0; w0.x = pk_bf16(O0[4 * gq] * inv, O0[4 * gq + 1] * inv); w0.y = pk_bf16(O0[4 * gq + 2] * inv, O0[4 * gq + 3] * inv);
                                u32x2 w1; w1.x = pk_bf16(O1[4 * gq] * inv, O1[4 * gq + 1] * inv); w1.y = pk_bf16(O1[4 * gq + 2] * inv, O1[4 * gq + 3] * inv);
                                *(LAS u32x2*)(tw + 16 * gq) = w0; *(LAS u32x2*)(tw + 64 + 16 * gq) = w1;
                            }
                        }
                        asm volatile("" ::: "memory");
                        const u32x4 ov0 = *(const LAS u32x4*)tr, ov1 = *(const LAS u32x4*)(tr + 8 * 144);
                        asm volatile("" ::: "memory");
                        __builtin_nontemporal_store(ov0, (u32x4*)(op + (size_t)(16 * ps2) * D)); __builtin_nontemporal_store(ov1, (u32x4*)(op + (size_t)(16 * ps2 + 8) * D));
                    }
                    e_prev += 1;
                }
            }
        }
        asm volatile("s_waitcnt vmcnt(0) lgkmcnt(0)" ::: "memory"); __builtin_amdgcn_s_barrier(); asm volatile("" ::: "memory");
    }
#undef AT_ISSUE
#undef AT_QDMA
#undef AT_SCORES
#undef AT_SOFTPV
}

constexpr int N_PHASES = 22;
#ifndef DUPMASK
#define DUPMASK 0
#endif
#define REP(bit) for (int rep_ = 0; rep_ < (((DUPMASK) & (bit)) ? 2 : 1); ++rep_)
#define REPBAR() do { if (rep_) xcd_barrier(bar); } while (0)
typedef const Args __attribute__((address_space(4))) KArgs;
#define KARGS() ({ KArgs* p_ = (KArgs*)__builtin_amdgcn_kernarg_segment_ptr(); asm volatile("" : "+s"(p_)); p_; })
__global__ void __launch_bounds__(NWAVES * 64, 2) yoco_fwd(Args args_unused) {
    extern __shared__ __attribute__((aligned(16))) unsigned char lds[];
    Frame F;
    F.lds = (LAS unsigned char*)lds;
    F.tid = threadIdx.x; F.lane = F.tid & 63; F.wave = __builtin_amdgcn_readfirstlane(F.tid >> 6);
    F.G = gridDim.x; F.bx = blockIdx.x;
    for (int u = F.tid; u < (LDS_BYTES - LDSCTL_OFF) / 4; u += NWAVES * 64) ((LAS unsigned*)(F.lds + LDSCTL_OFF))[u] = 0u;
    __syncthreads();
    volatile LAS unsigned* MISC = (volatile LAS unsigned*)(F.lds + MISC_OFF);
    int lo, hi;
    XcdBarrier bar;
    { KArgs* ap = KARGS(); lo = ap->ph_lo; hi = ap->ph_hi; bar = xcd_barrier_post((unsigned*)(ap->ws + WS_CTL) + CW_BAR, MISC + 8); }
#define IN(k) (lo <= (k) && (k) < hi)
#define SEAM(k) do { if (IN(k) && IN((k) + 1)) xcd_barrier(bar); } while (0)
    LAS unsigned char* ring = F.lds;

    if (IN(0)) REP(1) { REPBAR(); KArgs* ap = KARGS();
        Args a0;
#pragma unroll
        for (int i = 0; i < 16; ++i) a0.in[i] = ap->in[i];
        a0.out = ap->out; a0.ws = ap->ws; a0.ph_lo = 0; a0.ph_hi = 0;
        p0_prologue(F, a0); xconv_phase(F, a0.in[I_X], (bf16*)(a0.ws + WS_H), (u64*)(a0.ws + WS_SSQ)); }
    SEAM(0);

    for (int l = 0; l < 4; ++l) {
        const int p = 1 + 5 * l;
        if (IN(p)) REP(4) { REPBAR(); KArgs* ap = KARGS(); unsigned char* ws = ap->ws;
            bf16* H = (bf16*)(ws + WS_H); bf16* BIG = (bf16*)(ws + WS_BIG); const u64* ssq_in = (const u64*)(ws + WS_SSQ) + (size_t)(2 * l) * M;
            const bf16* wn; int nn; bf16* on; int ldn, splitc; bf16* on2;
            const bf16* wsw; int msw; bf16* osw;
            if (l < 2) {
                unsigned char* wb = ws + WS_WA + (size_t)l * WA_STRIDE;
                gates_phase(F, H, ssq_in, (const bf16*)(wb + WA_G), ap->in[I_ABG] + l * 16, (float*)(ws + WS_GATES));
                wn = (const bf16*)(wb + WA_QKO); nn = 2048; on = BIG; ldn = 2048; splitc = 0; on2 = nullptr;
                wsw = (const bf16*)(wb + WA_KV); msw = 1024; osw = (bf16*)(ws + WS_KVT);
            } else if (l == 2) {
                bf16* KB = (bf16*)ap->out;
                wn = (const bf16*)(ws + WS_WQK2); nn = 2048; on = BIG; ldn = 1024; splitc = 1024; on2 = KB;
                wsw = (const bf16*)(ws + WS_WV); msw = 1024; osw = KB + (size_t)M * D;
            } else {
                wn = (const bf16*)(ws + WS_WQ3); nn = 1024; on = BIG; ldn = 1024; splitc = 0; on2 = nullptr;
                wsw = nullptr; msw = 0; osw = nullptr;
            }
            { pg8::Gemm g{H, wn, M, nn, D}; pg8::StaticOrder S; S.init(M, nn, F.G, F.bx);
              pg8::EpiBf16 E{on, ldn, splitc, on2, ssq_in};
              pg8::gemm_phase<pg8::EpiBf16, pg8::StaticOrder, true, true>(ring, g, S, E); }
            if (msw) { pg8::Gemm g{wsw, H, msw, M, D}; pg8::StaticOrder S; S.init(msw, M, F.G, F.bx);
              pg8::EpiBf16K E{osw, M, 0, nullptr, ssq_in};
              pg8::gemm_phase<pg8::EpiBf16K, pg8::StaticOrder, true, true>(ring, g, S, E); }
        }
        SEAM(p);
        if (IN(p + 1)) REP(l < 2 ? 8 : 16) { REPBAR(); KArgs* ap = KARGS(); unsigned char* ws = ap->ws;
            bf16* BIG = (bf16*)(ws + WS_BIG); bf16* XN = (bf16*)(ws + WS_XN);
            if (l < 2) mlstm_phase(F, BIG, (const bf16*)(ws + WS_KVT), (const float*)(ws + WS_GATES), ap->in[I_AGH] + l * D, XN);
            else { const bf16* KB = (const bf16*)ap->out; attn_phase(F, BIG, KB, KB + (size_t)M * D, ap->in[I_BREL] + (size_t)(l - 2) * BH * NREL, XN); }
        }
        SEAM(p + 1);
        if (IN(p + 2)) { KArgs* ap = KARGS(); unsigned char* ws = ap->ws;
            const bf16* wo = (l < 2) ? (const bf16*)(ws + WS_WA + (size_t)l * WA_STRIDE + WA_OUT) : (const bf16*)(ws + WS_WO + (size_t)(l - 2) * 2 * MiB);
            pg8::Gemm g{(const bf16*)(ws + WS_XN), wo, M, D, D}; pg8::StaticOrderC<M / 256, D / 256> S; S.init(M, D, F.G, F.bx);
            pg8::EpiRes E{(bf16*)(ws + WS_H), (u64*)(ws + WS_SSQ) + (size_t)(2 * l + 1) * M};
            pg8::gemm_phase<pg8::EpiRes, pg8::StaticOrderC<M / 256, D / 256>, true, true>(ring, g, S, E);
        }
        SEAM(p + 2);
        if (IN(p + 3)) REP(64) { REPBAR(); KArgs* ap = KARGS(); unsigned char* ws = ap->ws;
            pg8::Gemm g{(const bf16*)(ws + WS_H), (const bf16*)(ws + WS_WF + (size_t)l * WF_STRIDE), M, 2 * FF, D}; pg8::StaticOrderC<M / 256, 2 * FF / 256> S; S.init(M, 2 * FF, F.G, F.bx);
            pg8::EpiSwiglu E{(bf16*)(ws + WS_BIG), FF, (const u64*)(ws + WS_SSQ) + (size_t)(2 * l + 1) * M};
            pg8::gemm_phase<pg8::EpiSwiglu, pg8::StaticOrderC<M / 256, 2 * FF / 256>, true, true>(ring, g, S, E);
        }
        SEAM(p + 3);
        if (IN(p + 4)) { KArgs* ap = KARGS(); unsigned char* ws = ap->ws;
            pg8::Gemm g{(const bf16*)(ws + WS_BIG), (const bf16*)(ws + WS_WF + (size_t)l * WF_STRIDE + WF_D), M, D, FF}; pg8::StaticOrderC<M / 256, D / 256> S; S.init(M, D, F.G, F.bx);
            pg8::EpiRes E{(bf16*)(ws + WS_H), (u64*)(ws + WS_SSQ) + (size_t)(2 * l + 2) * M};
            pg8::gemm_phase<pg8::EpiRes, pg8::StaticOrderC<M / 256, D / 256>, true, true>(ring, g, S, E);
        }
        SEAM(p + 4);
    }
    if (IN(21)) REP(128) { REPBAR(); KArgs* ap = KARGS(); unsigned char* ws = ap->ws;
        final_norm_phase(F, (const bf16*)(ws + WS_H), (const u64*)(ws + WS_SSQ) + (size_t)8 * M, ap->in[I_FING], ap->out); }
#undef IN
#undef SEAM
}

extern "C" void kernel_launch(void* const* d_in, const int* in_sizes, int n_in, void* d_out, int out_size, void* d_ws, size_t ws_size, hipStream_t stream) {
    static int grid = 0;
    if (grid == 0) {
        if (n_in != 16 || out_size != M * D || ws_size < WS_END) { fprintf(stderr, "kernel_launch: unexpected shapes (n_in %d, out %d, ws %zu < %zu)\n", n_in, out_size, ws_size, (size_t)WS_END); }
        int dev = 0, cus = 0, per_cu = 0;
        hipGetDevice(&dev); hipDeviceGetAttribute(&cus, hipDeviceAttributeMultiprocessorCount, dev);
        hipFuncSetAttribute((const void*)yoco_fwd, hipFuncAttributeMaxDynamicSharedMemorySize, LDS_BYTES);
        hipOccupancyMaxActiveBlocksPerMultiprocessor(&per_cu, (const void*)yoco_fwd, NWAVES * 64, LDS_BYTES);
        (void)hipGetLastError();
        grid = cus > 0 ? cus : 256;
        if (per_cu < 1) fprintf(stderr, "kernel_launch: occupancy query says %d\n", per_cu);
    }
    hipMemsetAsync((char*)d_ws + WS_CTL, 0, CTL_ZERO_BYTES, stream);
    Args a{};
    for (int i = 0; i < 16; ++i) a.in[i] = (const float*)d_in[i];
    a.out = (float*)d_out; a.ws = (unsigned char*)d_ws;
#if MK_N_LAUNCHES == 1
    a.ph_lo = 0; a.ph_hi = N_PHASES;
    hipLaunchKernelGGL(yoco_fwd, dim3(grid), dim3(NWAVES * 64), LDS_BYTES, stream, a);
#else
    for (int p = 0; p < N_PHASES; ++p) { a.ph_lo = p; a.ph_hi = p + 1; hipLaunchKernelGGL(yoco_fwd, dim3(grid), dim3(NWAVES * 64), LDS_BYTES, stream, a); }
#endif
}
```
